# Optimizing an MI355X kernel written in HIP

```python
import math
import jax, jax.numpy as jnp
from jax import lax
import numpy as np

D_MODEL = 1024
BATCH = 2
SEQ = 16384
DEPTH = 2

N_MIXERS = 2
EXPAND = 2
D_INNER = EXPAND * D_MODEL
EPS = 1e-6

HG_DK = 128
HG_HEADS = D_INNER // HG_DK
HG_DV = D_INNER // HG_HEADS
HG_CHUNK = 32

ATT_HEAD_DIM = 128
ATT_HEADS = D_INNER // ATT_HEAD_DIM
DILATED_GROUPS = ((128, 1), (512, 4), (2048, 16))
N_GROUPS = len(DILATED_GROUPS)
ATT_BLOCK = 128
N_BUCKETS = 32
MAX_DISTANCE = 2048

N_A = (DEPTH + 1) // 2
N_B = DEPTH // 2
ATT_IN_COLS = (3 * N_GROUPS + 1) * D_INNER
HG_IN_COLS = 4 * D_INNER

kernel_name = "hgrn2_dilated_swa_interleaved_hybrid"


def rmsnorm(x, g):
    xf = x.astype(jnp.float32)
    y = xf * lax.rsqrt(jnp.mean(xf * xf, axis=-1, keepdims=True) + EPS)
    return (y * g.astype(jnp.float32)).astype(x.dtype)


def proj_cols(u, w, start, width):
    return u @ w[:, start:start + width]


def hgrn2_mixer(u, w_in, lb, norm_g, w_out):
    B, S, _ = u.shape
    W = D_INNER
    q = proj_cols(u, w_in, 0, W)
    f_pre = proj_cols(u, w_in, W, W)
    i_in = proj_cols(u, w_in, 2 * W, W)
    gate = proj_cols(u, w_in, 3 * W, W)

    f = lb + (1.0 - lb) * jax.nn.sigmoid(f_pre.astype(jnp.float32))
    log_f = jnp.log(f)
    k = 1.0 - f
    n_chunks = S // HG_CHUNK

    def chunks(t):
        t = t.astype(jnp.float32).reshape(B, n_chunks, HG_CHUNK, HG_HEADS, -1)
        return t.transpose(1, 0, 3, 2, 4)

    causal = jnp.tril(jnp.ones((HG_CHUNK, HG_CHUNK), dtype=bool))

    def step(state, xs):
        q_c, k_c, lf_c, v_c = xs
        b = jnp.cumsum(lf_c, axis=2)
        b_last = b[:, :, -1:, :]
        q_dec = q_c * jnp.exp(b)
        scores = jnp.einsum('bhcd,bhsd->bhcs', q_dec, k_c * jnp.exp(-b))
        scores = jnp.where(causal, scores, 0.0)
        o = (jnp.einsum('bhcs,bhse->bhce', scores, v_c)
             + jnp.einsum('bhcd,bhde->bhce', q_dec, state))
        state = (jnp.exp(b_last[:, :, 0, :])[..., None] * state
                 + jnp.einsum('bhcd,bhce->bhde', k_c * jnp.exp(b_last - b), v_c))
        return state, o

    s0 = jnp.zeros((B, HG_HEADS, HG_DK, HG_DV), jnp.float32)
    _, o = lax.scan(step, s0, (chunks(q), chunks(k), chunks(log_f), chunks(i_in)))
    o = o.transpose(1, 0, 3, 2, 4).reshape(B, S, HG_HEADS, HG_DV)
    o = o * lax.rsqrt(jnp.mean(o * o, axis=-1, keepdims=True) + EPS)
    o = o.reshape(B, S, D_INNER) * norm_g.astype(jnp.float32)
    y = o * jax.nn.silu(gate.astype(jnp.float32))
    return y.astype(u.dtype) @ w_out


def t5_bucket(dist):
    max_exact = N_BUCKETS // 2
    df = jnp.maximum(dist, 1).astype(jnp.float32)
    large = max_exact + (jnp.log(df / max_exact) / math.log(MAX_DISTANCE / max_exact)
                         * (N_BUCKETS - max_exact)).astype(jnp.int32)
    large = jnp.minimum(large, N_BUCKETS - 1)
    return jnp.where(dist < max_exact, dist, large)


def dilated_group(q, k, v, bias_table, window, dilation):
    B, S, H, E = q.shape
    d = dilation
    L = S // d
    n_blk = -(-L // ATT_BLOCK)
    Lp = n_blk * ATT_BLOCK
    sub_window = window // d

    def by_residue(t):
        t = t.reshape(B, L, d, H, E).transpose(0, 2, 1, 3, 4)
        return jnp.pad(t, ((0, 0), (0, 0), (0, Lp - L), (0, 0), (0, 0)))

    def banded(t):
        t = jnp.pad(t, ((0, 0), (0, 0), (ATT_BLOCK, 0), (0, 0), (0, 0)))
        t = t.reshape(B, d, n_blk + 1, ATT_BLOCK, H, E)
        return jnp.concatenate([t[:, :, :-1], t[:, :, 1:]], axis=3)

    qb = by_residue(q).reshape(B, d, n_blk, ATT_BLOCK, H, E)
    kb = banded(by_residue(k))
    vb = banded(by_residue(v))

    a = jnp.arange(ATT_BLOCK)[:, None]
    c = jnp.arange(2 * ATT_BLOCK)[None, :]
    rel = ATT_BLOCK + a - c
    band = (rel >= 0) & (rel <= sub_window)
    kpos = (jnp.arange(n_blk)[:, None, None] - 1) * ATT_BLOCK + c[None]
    mask = band[None] & (kpos >= 0)
    bucket = t5_bucket(jnp.maximum(rel, 0) * d)
    bias = bias_table[bucket].astype(jnp.float32).transpose(2, 0, 1)

    s = jnp.einsum('brnqhe,brnkhe->brnhqk', qb, kb,
                   preferred_element_type=jnp.float32) * (E ** -0.5) + bias
    s = jnp.where(mask[None, None, :, None], s, -1e30)
    m = jnp.max(s, axis=-1, keepdims=True)
    p = jnp.exp(s - m)
    den = jnp.sum(p, axis=-1)
    o = jnp.einsum('brnhqk,brnkhe->brnqhe', p, vb.astype(jnp.float32))
    o = o / den.transpose(0, 1, 2, 4, 3)[..., None]
    lse = (m[..., 0] + jnp.log(den)).transpose(0, 1, 2, 4, 3)

    o = o.reshape(B, d, Lp, H, E)[:, :, :L].transpose(0, 2, 1, 3, 4).reshape(B, S, H, E)
    lse = lse.reshape(B, d, Lp, H)[:, :, :L].transpose(0, 2, 1, 3).reshape(B, S, H)
    return o, lse


def dilated_attention_mixer(u, w_in, rel_bias, w_out):
    B, S, _ = u.shape
    W = D_INNER
    outs, lses = [], []
    for g, (window, dilation) in enumerate(DILATED_GROUPS):
        base = 3 * g * W
        q = proj_cols(u, w_in, base, W).reshape(B, S, ATT_HEADS, ATT_HEAD_DIM)
        k = proj_cols(u, w_in, base + W, W).reshape(B, S, ATT_HEADS, ATT_HEAD_DIM)
        v = proj_cols(u, w_in, base + 2 * W, W).reshape(B, S, ATT_HEADS, ATT_HEAD_DIM)
        table = rel_bias[:, g * ATT_HEADS:(g + 1) * ATT_HEADS]
        o, lse = dilated_group(q, k, v, table, window, dilation)
        outs.append(o)
        lses.append(lse)
    wts = jax.nn.softmax(jnp.stack(lses, axis=0), axis=0)
    o = jnp.einsum('gbsh,gbshe->bshe', wts, jnp.stack(outs, axis=0)).reshape(B, S, W)
    gate = proj_cols(u, w_in, 3 * N_GROUPS * W, W)
    y = o * jax.nn.silu(gate.astype(jnp.float32))
    return y.astype(u.dtype) @ w_out


def setup_inputs(seed: int = 0) -> dict:
    key = jax.random.key(seed)
    ks = jax.random.split(key, 10)
    f32 = jnp.float32
    x = jax.random.normal(ks[0], (BATCH, SEQ, D_MODEL), f32)
    ln_g = 1.0 + 0.02 * jax.random.normal(ks[1], (DEPTH, D_MODEL), f32)
    hg_w_in = jax.random.normal(ks[2], (N_A, D_MODEL, HG_IN_COLS), f32) * D_MODEL ** -0.5
    hg_lb_logits = 0.1 * jax.random.normal(ks[3], (DEPTH + 1, D_INNER), f32)
    hg_norm_g = 1.0 + 0.02 * jax.random.normal(ks[4], (N_A, D_INNER), f32)
    hg_w_out = jax.random.normal(ks[5], (N_A, D_INNER, D_MODEL), f32) * D_INNER ** -0.5
    att_w_in = jax.random.normal(ks[6], (N_B, D_MODEL, ATT_IN_COLS), f32) * D_MODEL ** -0.5
    att_w_out = jax.random.normal(ks[7], (N_B, D_INNER, D_MODEL), f32) * D_INNER ** -0.5
    rel_bias = 0.2 * jax.random.normal(ks[8], (N_BUCKETS, N_GROUPS * ATT_HEADS), f32)
    final_g = 1.0 + 0.02 * jax.random.normal(ks[9], (D_MODEL,), f32)
    return {"x": x, "ln_g": ln_g, "hg_w_in": hg_w_in, "hg_lb_logits": hg_lb_logits,
            "hg_norm_g": hg_norm_g, "hg_w_out": hg_w_out, "att_w_in": att_w_in,
            "att_w_out": att_w_out, "rel_bias": rel_bias, "final_g": final_g}


def reference(x, ln_g, hg_w_in, hg_lb_logits, hg_norm_g, hg_w_out, att_w_in, att_w_out,
              rel_bias, final_g):
    lower_bounds = jnp.cumsum(jax.nn.softmax(hg_lb_logits.astype(jnp.float32), axis=0), axis=0)
    h = x
    for i in range(DEPTH):
        u = rmsnorm(h, ln_g[i])
        j = i // N_MIXERS
        if i % N_MIXERS == 0:
            y = hgrn2_mixer(u, hg_w_in[j], lower_bounds[i], hg_norm_g[j], hg_w_out[j])
        else:
            y = dilated_attention_mixer(u, att_w_in[j], rel_bias, att_w_out[j])
        h = h + y.astype(h.dtype)
    return rmsnorm(h, final_g)
```

```cpp
#include <hip/hip_runtime.h>
#include <hip/hip_cooperative_groups.h>
#include <cstdio>
#include <cstdint>
namespace cg = cooperative_groups;
namespace pg8 {
#define PG8_LAS __attribute__((address_space(3)))
typedef unsigned short bf16_t;
typedef short bf16x8 __attribute__((ext_vector_type(8)));
typedef float f32x4 __attribute__((ext_vector_type(4)));
typedef unsigned u32x4 __attribute__((ext_vector_type(4)));
constexpr int BM = 256, BK = 64, HALF = 128, HTB = HALF * BK * 2  , STAGE_BYTES = 8 * HTB, NXCD = 8, WGM = 8;

__host__ __device__ __forceinline__ int lds_byte(int r, int c) { const int st = (r >> 4) * 2 + (c >> 5), rr = r & 15, cc = c & 31, ob = rr * 64 + cc * 2; return st * 1024 + (ob ^ (((ob >> 9) & 1) << 5)); }
__host__ __device__ __forceinline__ void stage_rc(int b, int& R, int& C) { const int st = b / 1024, sb = b % 1024, swz = sb ^ (((sb >> 9) & 1) << 5); R = (st >> 1) * 16 + swz / 64; C = (st & 1) * 32 + (swz % 64) / 2; }
__host__ __device__ __forceinline__ int perm32(int rho) { const int n = rho >> 4, i = rho & 15; return 8 * (i >> 2) + 4 * n + (i & 3); }

struct Unit { int pm, pn; };
struct Gemm { const bf16_t* A; const bf16_t* Bt; int M, N, K; };

struct StaticOrder {
    int nM, nN, nwg, G, c;
    __host__ __device__ void init(int M, int N, int G_, int c_) { nM = M / BM; nN = N / BM; nwg = nM * nN; G = G_; c = c_; }
    __host__ __device__ bool next(int i, Unit& u) const {
        const long L = (long)i * G + c; if (L >= nwg) return false;
        int wgid = (int)L; { const int q = nwg / NXCD, r = nwg % NXCD, xcd = wgid % NXCD, off = wgid / NXCD; wgid = (xcd < r ? xcd * (q + 1) : r * (q + 1) + (xcd - r) * q) + off; }
        const int nig = WGM * nN, gid = wgid / nig, fm = gid * WGM, gsz = (nM - fm) < WGM ? (nM - fm) : WGM;
        u.pm = fm + ((wgid % nig) % gsz); u.pn = (wgid % nig) / gsz; return true;
    }
    __device__ __forceinline__ void a_ready(const Unit&) const {}
    __device__ __forceinline__ void done(const Unit&) const {}
};

__device__ __forceinline__ unsigned cvt_pk_bf16(float lo, float hi) { unsigned r; asm volatile("v_cvt_pk_bf16_f32 %0, %1, %2" : "=v"(r) : "v"(lo), "v"(hi)); return r; }
__device__ __forceinline__ float bf_lo(unsigned w) { return __uint_as_float(w << 16); }
__device__ __forceinline__ float bf_hi(unsigned w) { return __uint_as_float(w & 0xffff0000u); }
struct EpiBf16 {
    static constexpr bool PERM = true, AFTER_DRAIN = false;
    bf16_t* O; int ldc;
    __device__ __forceinline__ void operator()(const f32x4 (&acc)[2][2][4][2], const Unit& u, int wr, int wc, int fr, int fq) const {
        const int row0 = u.pm * BM + wr * 64 + fr, col0 = u.pn * BM + wc * 32 + 8 * fq;
#pragma unroll
        for (int ai = 0; ai < 2; ++ai)
#pragma unroll
            for (int m = 0; m < 4; ++m) { bf16_t* rowp = O + (size_t)(row0 + ai * HALF + m * 16) * ldc + col0;
#pragma unroll
                for (int bj = 0; bj < 2; ++bj) { const f32x4 v0 = acc[ai][bj][m][0], v1 = acc[ai][bj][m][1];
                    u32x4 w; w.x = cvt_pk_bf16(v0[0], v0[1]); w.y = cvt_pk_bf16(v0[2], v0[3]); w.z = cvt_pk_bf16(v1[0], v1[1]); w.w = cvt_pk_bf16(v1[2], v1[3]);
                    *(u32x4*)(rowp + bj * HALF) = w; } }
    }
};
struct EpiResF32 {
    static constexpr bool PERM = false, AFTER_DRAIN = false;
    const float* base; float* out; int ldc;
    __device__ __forceinline__ void operator()(const f32x4 (&acc)[2][2][4][2], const Unit& u, int wr, int wc, int fr, int fq) const {
        const int row0 = u.pm * BM + wr * 64 + fr, col0 = u.pn * BM + wc * 32 + 4 * fq;
#pragma unroll
        for (int ai = 0; ai < 2; ++ai)
#pragma unroll
            for (int m = 0; m < 4; ++m) { const size_t off = (size_t)(row0 + ai * HALF + m * 16) * ldc + col0;
#pragma unroll
                for (int bj = 0; bj < 2; ++bj)
#pragma unroll
                    for (int n = 0; n < 2; ++n) { const f32x4 b = *(const f32x4*)(base + off + bj * HALF + n * 16); *(f32x4*)(out + off + bj * HALF + n * 16) = b + acc[ai][bj][m][n]; } }
    }
};
struct EpiGateMul {
    static constexpr bool PERM = true, AFTER_DRAIN = false;
    bf16_t* O; int ldc;
    __device__ __forceinline__ float sg(float o, float g) const { return o * g / (1.0f + __expf(-g)); }
    __device__ __forceinline__ void operator()(const f32x4 (&acc)[2][2][4][2], const Unit& u, int wr, int wc, int fr, int fq) const {
        const int row0 = u.pm * BM + wr * 64 + fr, col0 = u.pn * BM + wc * 32 + 8 * fq;
#pragma unroll
        for (int ai = 0; ai < 2; ++ai)
#pragma unroll
            for (int m = 0; m < 4; ++m) { bf16_t* rowp = O + (size_t)(row0 + ai * HALF + m * 16) * ldc + col0;
#pragma unroll
                for (int bj = 0; bj < 2; ++bj) { const f32x4 v0 = acc[ai][bj][m][0], v1 = acc[ai][bj][m][1];
                    const u32x4 ov = *(const u32x4*)(rowp + bj * HALF);
                    u32x4 w; w.x = cvt_pk_bf16(sg(bf_lo(ov.x), v0[0]), sg(bf_hi(ov.x), v0[1])); w.y = cvt_pk_bf16(sg(bf_lo(ov.y), v0[2]), sg(bf_hi(ov.y), v0[3]));
                    w.z = cvt_pk_bf16(sg(bf_lo(ov.z), v1[0]), sg(bf_hi(ov.z), v1[1])); w.w = cvt_pk_bf16(sg(bf_lo(ov.w), v1[2]), sg(bf_hi(ov.w), v1[3]));
                    *(u32x4*)(rowp + bj * HALF) = w; } }
    }
};
template <class Epi, class Sched, bool ALIGN_EPI = false, bool SP2 = false>
__device__ __forceinline__ void gemm_phase(PG8_LAS unsigned char* lds, const Gemm g, const Sched& S, const Epi& E) {
    const int tid = threadIdx.x, wid = __builtin_amdgcn_readfirstlane(tid >> 6), lane = tid & 63, wr = wid >> 2, wc = wid & 3, fr = lane & 15, fq = lane >> 4;
    const int K = g.K, nt = K / BK;
    unsigned voffA[2], voffB[2];
#pragma unroll
    for (int i = 0; i < 2; ++i) { int R, C; stage_rc(tid * 16 + i * 8192, R, C); const int Rb = Epi::PERM ? ((R & ~31) + perm32(R & 31)) : R;
        voffA[i] = (unsigned)(R * K + C) * 2u; voffB[i] = (unsigned)(Rb * K + C) * 2u; }
    const size_t kstep = (size_t)(BK * 2);
    const size_t hstep = (size_t)HALF * K * 2;
    const size_t tstep = 2 * hstep;
    const unsigned ldsw = (unsigned)wid * 1024u;
    const int aoff = lds_byte(wr * 64 + fr, fq * 8), boff = lds_byte(wc * 32 + fr, fq * 8);
#define PG8_SA(b, h) (((b) * 2 + (h)) * HTB)
#define PG8_SB(b, h) ((4 + (b) * 2 + (h)) * HTB)
#define PG8_STAGE(bufoff, gbase, voff) do { _Pragma("unroll") for (int _i = 0; _i < 2; ++_i) \
        __builtin_amdgcn_global_load_lds((const unsigned*)((const char*)(gbase) + (voff)[_i]), (PG8_LAS unsigned*)(lds + (bufoff) + ldsw + _i * 8192), 16, 0, 0); } while (0)
#define PG8_LDA(dst, b, h) do { _Pragma("unroll") for (int m = 0; m < 4; ++m) _Pragma("unroll") for (int k = 0; k < 2; ++k) dst[m][k] = *(const PG8_LAS bf16x8*)(lds + PG8_SA(b, h) + aoff + m * 2048 + k * 1024); } while (0)
#define PG8_LDB(dst, b, h) do { _Pragma("unroll") for (int n = 0; n < 2; ++n) _Pragma("unroll") for (int k = 0; k < 2; ++k) dst[n][k] = *(const PG8_LAS bf16x8*)(lds + PG8_SB(b, h) + boff + n * 2048 + k * 1024); } while (0)
#define PG8_MMA(ai, bj, At, Bt) do { __builtin_amdgcn_s_setprio(1); _Pragma("unroll") for (int m = 0; m < 4; ++m) _Pragma("unroll") for (int n = 0; n < 2; ++n) _Pragma("unroll") for (int k = 0; k < 2; ++k) \
        acc[ai][bj][m][n] = __builtin_amdgcn_mfma_f32_16x16x32_bf16(Bt[n][k], At[m][k], acc[ai][bj][m][n], 0, 0, 0); __builtin_amdgcn_s_setprio(0); } while (0)
#define PG8_WAIT_V(n) asm volatile("s_waitcnt vmcnt(" #n ")" ::: "memory")
#define PG8_WAIT_L(n) asm volatile("s_waitcnt lgkmcnt(" #n ")" ::: "memory")
#define PG8_BAR __builtin_amdgcn_s_barrier()
#define PG8_SCHED __builtin_amdgcn_sched_barrier(0)
    Unit cur, nxt; int ui = 0;
    if (!S.next(0, cur)) return;
    f32x4 acc[2][2][4][2];
#pragma unroll
    for (int a = 0; a < 2; ++a)
#pragma unroll
        for (int b = 0; b < 2; ++b)
#pragma unroll
            for (int m = 0; m < 4; ++m)
#pragma unroll
                for (int n = 0; n < 2; ++n) acc[a][b][m][n] = (f32x4){0.f, 0.f, 0.f, 0.f};
    bf16x8 At[4][2], B0[2][2], B1[2][2];
    const char* cA = (const char*)g.A + (size_t)cur.pm * tstep; const char* cB = (const char*)g.Bt + (size_t)cur.pn * tstep;
    S.a_ready(cur);
    if constexpr (SP2) {
        PG8_STAGE(PG8_SB(0, 0), cB, voffB); PG8_STAGE(PG8_SB(0, 1), cB + hstep, voffB); PG8_STAGE(PG8_SA(0, 0), cA, voffA); PG8_STAGE(PG8_SA(0, 1), cA + hstep, voffA);
        if (wr == 1) PG8_BAR;
        PG8_WAIT_V(2); PG8_BAR;
        PG8_STAGE(PG8_SB(1, 0), cB + kstep, voffB); PG8_STAGE(PG8_SA(1, 0), cA + kstep, voffA); PG8_STAGE(PG8_SB(1, 1), cB + hstep + kstep, voffB);
        PG8_WAIT_V(6); PG8_BAR;
    } else {
        PG8_STAGE(PG8_SB(0, 0), cB, voffB); PG8_STAGE(PG8_SA(0, 0), cA, voffA); PG8_STAGE(PG8_SB(0, 1), cB + hstep, voffB); PG8_STAGE(PG8_SA(0, 1), cA + hstep, voffA);
        if (wr == 1) PG8_BAR;
        PG8_WAIT_V(4); PG8_BAR;
        PG8_STAGE(PG8_SB(1, 0), cB + kstep, voffB); PG8_STAGE(PG8_SA(1, 0), cA + kstep, voffA); PG8_STAGE(PG8_SB(1, 1), cB + hstep + kstep, voffB);
        PG8_WAIT_V(6); PG8_BAR;
    }
    for (;;) {
        const bool has_next = S.next(ui + 1, nxt);
        const char* nA = has_next ? (const char*)g.A + (size_t)nxt.pm * tstep : cA; const char* nB = has_next ? (const char*)g.Bt + (size_t)nxt.pn * tstep : cB;
        for (int t = 0; t < nt; t += 2) {
            const bool last = (t == nt - 2);
            const char* a1 = cA + (size_t)(t + 1) * kstep;
            const char* a2 = last ? nA : cA + (size_t)(t + 2) * kstep; const char* b2 = last ? nB : cB + (size_t)(t + 2) * kstep;
            const char* a3 = a2 + kstep; const char* b3 = b2 + kstep;
            if (last && has_next) S.a_ready(nxt);
            if constexpr (SP2) {
            PG8_LDB(B0, 0, 0); PG8_LDB(B1, 0, 1); PG8_SCHED; PG8_LDA(At, 0, 0); PG8_STAGE(PG8_SA(1, 1), a1 + hstep, voffA);
            PG8_WAIT_V(8); PG8_WAIT_L(0); PG8_BAR; PG8_MMA(0, 0, At, B0); PG8_MMA(0, 1, At, B1); PG8_BAR; PG8_SCHED;
            PG8_LDA(At, 0, 1); PG8_STAGE(PG8_SB(0, 0), b2, voffB); PG8_STAGE(PG8_SB(0, 1), b2 + hstep, voffB); PG8_STAGE(PG8_SA(0, 0), a2, voffA);
            PG8_WAIT_V(8); PG8_WAIT_L(0); PG8_BAR; PG8_MMA(1, 0, At, B0); PG8_MMA(1, 1, At, B1); PG8_BAR; PG8_SCHED;
            PG8_LDB(B0, 1, 0); PG8_LDB(B1, 1, 1); PG8_SCHED; PG8_LDA(At, 1, 0); PG8_STAGE(PG8_SA(0, 1), a2 + hstep, voffA);
            PG8_WAIT_V(8); PG8_WAIT_L(0); PG8_BAR; PG8_MMA(0, 0, At, B0); PG8_MMA(0, 1, At, B1); PG8_BAR; PG8_SCHED;
            PG8_LDA(At, 1, 1); PG8_STAGE(PG8_SB(1, 0), b3, voffB); PG8_STAGE(PG8_SB(1, 1), b3 + hstep, voffB); PG8_STAGE(PG8_SA(1, 0), a3, voffA);
            PG8_WAIT_V(8); PG8_WAIT_L(0); PG8_BAR; PG8_MMA(1, 0, At, B0); PG8_MMA(1, 1, At, B1); PG8_BAR; PG8_SCHED;
            } else {
            PG8_LDB(B0, 0, 0); PG8_SCHED; PG8_LDA(At, 0, 0); PG8_STAGE(PG8_SA(1, 1), a1 + hstep, voffA);
            PG8_WAIT_L(8); PG8_BAR; PG8_WAIT_L(0); PG8_MMA(0, 0, At, B0); PG8_BAR; PG8_SCHED;
            PG8_LDB(B1, 0, 1); PG8_STAGE(PG8_SB(0, 0), b2, voffB);
            PG8_BAR; PG8_WAIT_L(0); PG8_MMA(0, 1, At, B1); PG8_BAR;
            PG8_LDA(At, 0, 1); PG8_STAGE(PG8_SA(0, 0), a2, voffA);
            PG8_BAR; PG8_WAIT_L(0); PG8_MMA(1, 0, At, B0); PG8_BAR; PG8_SCHED;
            PG8_STAGE(PG8_SB(0, 1), b2 + hstep, voffB);
            PG8_WAIT_V(6); PG8_BAR; PG8_MMA(1, 1, At, B1); PG8_BAR;
            PG8_LDB(B0, 1, 0); PG8_SCHED; PG8_LDA(At, 1, 0); PG8_STAGE(PG8_SA(0, 1), a2 + hstep, voffA);
            PG8_WAIT_L(8); PG8_BAR; PG8_WAIT_L(0); PG8_MMA(0, 0, At, B0); PG8_BAR; PG8_SCHED;
            PG8_LDB(B1, 1, 1); PG8_STAGE(PG8_SB(1, 0), b3, voffB);
            PG8_BAR; PG8_WAIT_L(0); PG8_MMA(0, 1, At, B1); PG8_BAR;
            PG8_LDA(At, 1, 1); PG8_STAGE(PG8_SA(1, 0), a3, voffA);
            PG8_BAR; PG8_WAIT_L(0); PG8_MMA(1, 0, At, B0); PG8_BAR; PG8_SCHED;
            PG8_STAGE(PG8_SB(1, 1), b3 + hstep, voffB);
            PG8_WAIT_V(6); PG8_BAR; PG8_MMA(1, 1, At, B1); PG8_BAR;
            }
        }
        if constexpr (ALIGN_EPI) { if (wr == 0) PG8_BAR; }
        if constexpr (!Epi::AFTER_DRAIN) { E(acc, cur, wr, wc, fr, fq); S.done(cur); }
        if (!has_next) break;
#pragma unroll
        for (int a = 0; a < 2; ++a)
#pragma unroll
            for (int b = 0; b < 2; ++b)
#pragma unroll
                for (int m = 0; m < 4; ++m)
#pragma unroll
                    for (int n = 0; n < 2; ++n) acc[a][b][m][n] = (f32x4){0.f, 0.f, 0.f, 0.f};
        cur = nxt; cA = nA; cB = nB; ++ui;
        if constexpr (ALIGN_EPI) { if (wr == 1) PG8_BAR; }
    }
    PG8_WAIT_V(0);
    if constexpr (!ALIGN_EPI) { if (wr == 0) PG8_BAR; }
    PG8_BAR;
    if constexpr (Epi::AFTER_DRAIN) { E.fused(acc, cur, wr, wc, fr, fq, lds, wid, lane); S.done(cur); }
#undef PG8_SA
#undef PG8_SB
#undef PG8_STAGE
#undef PG8_LDA
#undef PG8_LDB
#undef PG8_MMA
#undef PG8_WAIT_V
#undef PG8_WAIT_L
#undef PG8_BAR
#undef PG8_SCHED
}
}
#ifndef PG8_SP2
#define PG8_SP2 true
#endif
#ifndef PG8_ALIGN
#define PG8_ALIGN true
#endif
constexpr int NWAVES = 8;
constexpr int BATCH = 2, SEQ = 16384, DM = 1024, DI = 2048, T = BATCH * SEQ;
constexpr int HG_COLS = 4 * DI;
constexpr int ATT_COLS = 10 * DI;
constexpr int QKV_COLS = 3 * DI;
constexpr float EPS = 1e-6f;
constexpr size_t MiB = 1u << 20;
constexpr size_t WS_CTL = 0;
constexpr size_t WS_WHGIN = 1 * MiB, WS_WHGOUT = 17 * MiB, WS_WATTIN = 21 * MiB, WS_WATTOUT = 61 * MiB;
constexpr size_t WS_LSE = 65 * MiB;
constexpr size_t WS_BIG0 = 96 * MiB;
constexpr size_t WS_U1 = WS_BIG0, WS_QKV = WS_BIG0 + 64 * MiB;
constexpr size_t WS_BIG1 = 352 * MiB;
constexpr size_t WS_END = 480 * MiB;
constexpr int RING_BYTES = 131072;
constexpr int LDS_BYTES = 147456;
enum { PH_PRO = 0, PH_G1_0 = 1, PH_HGA_0 = 2, PH_HGB_0 = 3, PH_G1_1 = 4, PH_HGA_1 = 5, PH_HGB_1 = 6, PH_G2 = 7, PH_NORM1 = 8, PH_G3_0 = 9  , PH_GATE = 21, PH_G5 = 22, PH_FINAL = 23, PH_END = 24 };

#define LAS __attribute__((address_space(3)))
typedef unsigned short bf16;
typedef unsigned v4u __attribute__((ext_vector_type(4)));
typedef float f32x4 __attribute__((ext_vector_type(4)));
#define LDS_WAIT() asm volatile("s_waitcnt lgkmcnt(0)" ::: "memory")
__device__ __forceinline__ unsigned f2bf(float f) { unsigned u = __builtin_bit_cast(unsigned, f); return (u + 0x7fffu + ((u >> 16) & 1u)) >> 16; }
__device__ __forceinline__ unsigned pk2(float lo, float hi) { return f2bf(lo) | (f2bf(hi) << 16); }
__device__ __forceinline__ float bf2f(unsigned short b) { return __uint_as_float(((unsigned)b) << 16); }
__device__ __forceinline__ float blo(unsigned w) { return __uint_as_float(w << 16); }
__device__ __forceinline__ float bhi(unsigned w) { return __uint_as_float(w & 0xffff0000u); }
__device__ __forceinline__ float wave_sum(float v) {
#pragma unroll
    for (int o = 1; o < 64; o <<= 1) v += __shfl_xor(v, o);
    return v;
}
__device__ const unsigned char BUCKET[3][129] = {
{0,1,2,3,4,5,6,7,8,9,10,11,12,13,14,15,16,16,16,16,16,16,17,17,17,17,17,17,17,17,18,18,18,18,18,18,18,18,18,18,19,19,19,19,19,19,19,19,19,19,19,19,19,19,20,20,20,20,20,20,20,20,20,20,20,20,20,20,20,20,20,20,20,21,21,21,21,21,21,21,21,21,21,21,21,21,21,21,21,21,21,21,21,21,21,21,21,21,21,22,22,22,22,22,22,22,22,22,22,22,22,22,22,22,22,22,22,22,22,22,22,22,22,22,22,22,22,22,22},
{0,4,8,12,16,16,17,17,18,18,19,19,19,19,20,20,20,20,20,21,21,21,21,21,21,22,22,22,22,22,22,22,22,22,23,23,23,23,23,23,23,23,23,23,23,23,24,24,24,24,24,24,24,24,24,24,24,24,24,24,24,24,25,25,25,25,25,25,25,25,25,25,25,25,25,25,25,25,25,25,25,25,25,26,26,26,26,26,26,26,26,26,26,26,26,26,26,26,26,26,26,26,26,26,26,26,26,26,26,26,26,26,26,27,27,27,27,27,27,27,27,27,27,27,27,27,27,27,27},
{0,16,18,19,20,21,21,22,22,23,23,23,24,24,24,24,25,25,25,25,25,26,26,26,26,26,26,26,26,27,27,27,27,27,27,27,27,27,27,28,28,28,28,28,28,28,28,28,28,28,28,28,29,29,29,29,29,29,29,29,29,29,29,29,29,29,29,29,29,29,30,30,30,30,30,30,30,30,30,30,30,30,30,30,30,30,30,30,30,30,30,30,30,30,30,31,31,31,31,31,31,31,31,31,31,31,31,31,31,31,31,31,31,31,31,31,31,31,31,31,31,31,31,31,31,31,31,31,31}};

__device__ __forceinline__ void p0_transpose_item(const float* W, int K, int N, bf16* WT, LAS float* scr, int item, int lane) {
    const int nblk = N / 32, kb = item / nblk, nb = item % nblk, k0 = 64 * kb, n0 = 32 * nb;
#pragma unroll 8
    for (int i = 0; i < 32; ++i) { const int kk = 2 * i + (lane >> 5); scr[kk * 33 + (lane & 31)] = W[(size_t)(k0 + kk) * N + n0 + (lane & 31)]; }
    LDS_WAIT(); asm volatile("" ::: "memory");
    const int c = lane & 7;
#pragma unroll
    for (int j = 0; j < 4; ++j) { const int n = (lane >> 3) + 8 * j; const LAS float* s = scr + (8 * c) * 33 + n;
        v4u o; o.x = pk2(s[0 * 33], s[1 * 33]); o.y = pk2(s[2 * 33], s[3 * 33]); o.z = pk2(s[4 * 33], s[5 * 33]); o.w = pk2(s[6 * 33], s[7 * 33]);
        *(v4u*)(WT + (size_t)(n0 + n) * K + k0 + 8 * c) = o; }
    LDS_WAIT(); asm volatile("" ::: "memory");
}
__device__ __forceinline__ void rms_row_to_bf16(const float* xrow, const float* g, bf16* orow, int lane) {
    const f32x4* xr = (const f32x4*)xrow + lane; const f32x4* gr = (const f32x4*)g + lane;
    f32x4 v[4]; float s = 0.f;
#pragma unroll
    for (int j = 0; j < 4; ++j) { v[j] = xr[64 * j]; s += (v[j].x * v[j].x + v[j].y * v[j].y) + (v[j].z * v[j].z + v[j].w * v[j].w); }
    const float rs = 1.0f / sqrtf(wave_sum(s) * (1.0f / DM) + EPS);
    unsigned long long* o8 = (unsigned long long*)orow + lane;
#pragma unroll
    for (int j = 0; j < 4; ++j) { const f32x4 gv = gr[64 * j]; const f32x4 o = v[j] * rs * gv;
        o8[64 * j] = (unsigned long long)pk2(o.x, o.y) | ((unsigned long long)pk2(o.z, o.w) << 32); }
}
__device__ __forceinline__ void rms_row_inplace_f32(float* xrow, const float* g, int lane) {
    f32x4* xr = (f32x4*)xrow + lane; const f32x4* gr = (const f32x4*)g + lane;
    f32x4 v[4]; float s = 0.f;
#pragma unroll
    for (int j = 0; j < 4; ++j) { v[j] = xr[64 * j]; s += (v[j].x * v[j].x + v[j].y * v[j].y) + (v[j].z * v[j].z + v[j].w * v[j].w); }
    const float rs = 1.0f / sqrtf(wave_sum(s) * (1.0f / DM) + EPS);
#pragma unroll
    for (int j = 0; j < 4; ++j) { const f32x4 gv = gr[64 * j]; xr[64 * j] = v[j] * rs * gv; }
}

__global__ __launch_bounds__(128) void naive_hgrn(const bf16* __restrict__ qfig, const float* __restrict__ lb_logits, const float* __restrict__ norm_g, bf16* __restrict__ y) {
    const int h = blockIdx.x, e = threadIdx.x, col = h * 128 + e;
    __shared__ float sq[16][128], sf[16][128], sv[16][128], so[16][128];
    float S[128];
#pragma unroll
    for (int d = 0; d < 128; ++d) S[d] = 0.f;
    const float l0 = lb_logits[col], l1 = lb_logits[DI + col], l2 = lb_logits[2 * DI + col];
    const float mx = fmaxf(l0, fmaxf(l1, l2)); const float e0 = expf(l0 - mx), e1 = expf(l1 - mx), e2 = expf(l2 - mx);
    const float lb = e0 / (e0 + e1 + e2);
    for (int t0 = 0; t0 < SEQ; t0 += 16) {
        for (int c = 0; c < 16; ++c) { const bf16* row = qfig + (size_t)(t0 + c) * HG_COLS + col;
            sq[c][e] = bf2f(row[0]); const float fp = bf2f(row[DI]); sf[c][e] = lb + (1.f - lb) / (1.f + expf(-fp)); sv[c][e] = bf2f(row[2 * DI]); }
        __syncthreads();
        for (int c = 0; c < 16; ++c) { const float v = sv[c][e]; float o = 0.f;
#pragma unroll
            for (int d = 0; d < 128; ++d) { const float f = sf[c][d]; S[d] = f * S[d] + (1.f - f) * v; o += sq[c][d] * S[d]; }
            so[c][e] = o; }
        __syncthreads();
        const int w = e >> 6, lane = e & 63;
        for (int cc = 0; cc < 8; ++cc) { const int c = w * 8 + cc; const float a = so[c][lane], b2 = so[c][lane + 64];
            const float ss = wave_sum(a * a + b2 * b2);
            const float rs = 1.0f / sqrtf(ss * (1.0f / 128.0f) + EPS);
            const bf16* grow = qfig + (size_t)(t0 + c) * HG_COLS + 3 * DI + h * 128;
            bf16* yrow = y + (size_t)(t0 + c) * DI + h * 128;
            for (int k = 0; k < 2; ++k) { const int ee = lane + 64 * k; const float g = bf2f(grow[ee]); const float ov = (k ? b2 : a) * rs * norm_g[h * 128 + ee];
                yrow[ee] = (bf16)f2bf(ov * g / (1.f + expf(-g))); } }
        __syncthreads();
    }
}
__global__ __launch_bounds__(256) void naive_attn(const bf16* __restrict__ qkv, const float* __restrict__ rel_bias, bf16* __restrict__ oacc, float* __restrict__ lseacc, int g) {
    const int idx = blockIdx.x * 256 + threadIdx.x; const int h = idx & 15, t = idx >> 4;
    const int dil = g == 0 ? 1 : (g == 1 ? 4 : 16);
    const v4u* qp = (const v4u*)(qkv + (size_t)t * QKV_COLS + h * 128);
    float o[128];
#pragma unroll
    for (int i = 0; i < 128; ++i) o[i] = 0.f;
    float m = -1e30f, l = 0.f;
    for (int j = 0; j <= 128; ++j) { const int tk = t - j * dil; if (tk < 0) break;
        const v4u* kp = (const v4u*)(qkv + (size_t)tk * QKV_COLS + DI + h * 128);
        const v4u* vp = (const v4u*)(qkv + (size_t)tk * QKV_COLS + 2 * DI + h * 128);
        float s = 0.f;
#pragma unroll
        for (int i = 0; i < 16; ++i) { const v4u a = qp[i], b = kp[i];
            s += blo(a.x) * blo(b.x) + bhi(a.x) * bhi(b.x) + blo(a.y) * blo(b.y) + bhi(a.y) * bhi(b.y) + blo(a.z) * blo(b.z) + bhi(a.z) * bhi(b.z) + blo(a.w) * blo(b.w) + bhi(a.w) * bhi(b.w); }
        s = s * 0.08838834764831845f + rel_bias[(int)BUCKET[g][j] * 48 + g * 16 + h];
        const float mn = fmaxf(m, s); const float alpha = expf(m - mn), p = expf(s - mn);
        l = l * alpha + p; m = mn;
#pragma unroll
        for (int i = 0; i < 16; ++i) { const v4u b = vp[i];
            o[8 * i + 0] = o[8 * i + 0] * alpha + p * blo(b.x); o[8 * i + 1] = o[8 * i + 1] * alpha + p * bhi(b.x);
            o[8 * i + 2] = o[8 * i + 2] * alpha + p * blo(b.y); o[8 * i + 3] = o[8 * i + 3] * alpha + p * bhi(b.y);
            o[8 * i + 4] = o[8 * i + 4] * alpha + p * blo(b.z); o[8 * i + 5] = o[8 * i + 5] * alpha + p * bhi(b.z);
            o[8 * i + 6] = o[8 * i + 6] * alpha + p * blo(b.w); o[8 * i + 7] = o[8 * i + 7] * alpha + p * bhi(b.w); }
    }
    const float lse = m + logf(l);
    float wa = 0.f, wg = 1.0f / l, ln = lse;
    v4u* op = (v4u*)(oacc + (size_t)t * DI + h * 128);
    if (g > 0) { const float la = lseacc[t * 16 + h]; const float mm = fmaxf(la, lse); ln = mm + logf(expf(la - mm) + expf(lse - mm)); wa = expf(la - ln); wg = expf(lse - ln) / l; }
#pragma unroll
    for (int i = 0; i < 16; ++i) { v4u a = (v4u){0u, 0u, 0u, 0u}; if (g > 0) a = op[i];
        v4u r; r.x = pk2(wa * blo(a.x) + wg * o[8 * i + 0], wa * bhi(a.x) + wg * o[8 * i + 1]); r.y = pk2(wa * blo(a.y) + wg * o[8 * i + 2], wa * bhi(a.y) + wg * o[8 * i + 3]);
        r.z = pk2(wa * blo(a.z) + wg * o[8 * i + 4], wa * bhi(a.z) + wg * o[8 * i + 5]); r.w = pk2(wa * blo(a.w) + wg * o[8 * i + 6], wa * bhi(a.w) + wg * o[8 * i + 7]);
        op[i] = r; }
    lseacc[t * 16 + h] = ln;
}

__device__ __forceinline__ const void* ldp(LAS unsigned char* lds, int i) {
    const unsigned long long v = ((LAS unsigned long long*)(lds + RING_BYTES))[i];
    const unsigned lo = __builtin_amdgcn_readfirstlane((unsigned)v), hi = __builtin_amdgcn_readfirstlane((unsigned)(v >> 32));
    return (const void*)(((unsigned long long)hi << 32) | lo);
}
struct Args { const float* in[10]; float* out; unsigned char* ws; int lo, hi; };
__global__ void __launch_bounds__(NWAVES * 64, 2) fwd(Args args) {
    extern __shared__ __attribute__((aligned(16))) unsigned char lds_raw[];
    LAS unsigned char* lds = (LAS unsigned char*)lds_raw;
    cg::grid_group grid = cg::this_grid();
    const int tid = threadIdx.x, wave = __builtin_amdgcn_readfirstlane(tid >> 6);
    const int G = gridDim.x; const int bx = blockIdx.x;
    const int vcu = (G % 8 == 0) ? (bx % 8) * (G / 8) + bx / 8 : bx;
    const int gw = vcu * NWAVES + wave, NGW = G * NWAVES;
    { LAS unsigned long long* P = (LAS unsigned long long*)(lds + RING_BYTES);
      if (tid < 10) P[tid] = (unsigned long long)args.in[tid];
      if (tid == 10) P[10] = (unsigned long long)args.out;
      if (tid == 11) P[11] = (unsigned long long)args.ws;
      __syncthreads(); }
    const int ph_hi = args.hi;
    for (int ph = args.lo; ph < ph_hi; ++ph) {
        int lane = tid & 63; asm volatile("" : "+v"(lane) :: "memory");
        const float* x = (const float*)ldp(lds, 0); const float* ln_g = (const float*)ldp(lds, 1);
        unsigned char* ws = (unsigned char*)ldp(lds, 11); float* Hres = (float*)ldp(lds, 10); bf16* U0 = (bf16*)Hres;
        bf16* Whgin = (bf16*)(ws + WS_WHGIN); bf16* Whgout = (bf16*)(ws + WS_WHGOUT); bf16* Wattin = (bf16*)(ws + WS_WATTIN); bf16* Wattout = (bf16*)(ws + WS_WATTOUT);
        bf16* QFIG = (bf16*)(ws + WS_BIG0); bf16* U1 = (bf16*)(ws + WS_U1); bf16* QKV = (bf16*)(ws + WS_QKV); bf16* YB = (bf16*)(ws + WS_BIG1);
        if (ph == PH_PRO) {
            LAS float* scr = (LAS float*)(lds + wave * 16384);
            const float* hg_w_in = (const float*)ldp(lds, 2); const float* hg_w_out = (const float*)ldp(lds, 5); const float* att_w_in = (const float*)ldp(lds, 6); const float* att_w_out = (const float*)ldp(lds, 7);
            constexpr int I_A = (DM / 64) * (HG_COLS / 32), I_B = (DI / 64) * (DM / 32), I_C = (DM / 64) * (ATT_COLS / 32), I_D = I_B;
            for (int it = gw; it < I_A + I_B + I_C + I_D; it += NGW) {
                int r = it;
                if (r < I_A) { p0_transpose_item(hg_w_in, DM, HG_COLS, Whgin, scr, r, lane); continue; } r -= I_A;
                if (r < I_B) { p0_transpose_item(hg_w_out, DI, DM, Whgout, scr, r, lane); continue; } r -= I_B;
                if (r < I_C) { p0_transpose_item(att_w_in, DM, ATT_COLS, Wattin, scr, r, lane); continue; } r -= I_C;
                p0_transpose_item(att_w_out, DI, DM, Wattout, scr, r, lane);
            }
            for (int m = gw; m < T; m += NGW) rms_row_to_bf16(x + (size_t)m * DM, ln_g, U0 + (size_t)m * DM, lane);
        } else if (ph == PH_G1_0 || ph == PH_G1_1) {
            const int b = (ph == PH_G1_1);
            const pg8::Gemm g{U0 + (size_t)b * SEQ * DM, Whgin, SEQ, HG_COLS, DM}; const pg8::EpiBf16 E{QFIG, HG_COLS};
            pg8::StaticOrder S; S.init(SEQ, HG_COLS, G, bx);
            pg8::gemm_phase<pg8::EpiBf16, pg8::StaticOrder, PG8_ALIGN, PG8_SP2>(lds, g, S, E);
        } else if (ph >= PH_G3_0 && ph < PH_GATE && ((ph - PH_G3_0) & 1) == 0) {
            const int k = (ph - PH_G3_0) >> 1, gi = k >> 1, b = k & 1;
            const pg8::Gemm g{U1 + (size_t)b * SEQ * DM, Wattin + (size_t)gi * QKV_COLS * DM, SEQ, QKV_COLS, DM}; const pg8::EpiBf16 E{QKV, QKV_COLS};
            pg8::StaticOrder S; S.init(SEQ, QKV_COLS, G, bx);
            pg8::gemm_phase<pg8::EpiBf16, pg8::StaticOrder, PG8_ALIGN, PG8_SP2>(lds, g, S, E);
        } else if (ph == PH_G2 || ph == PH_G5) {
            pg8::Gemm g{YB, ph == PH_G2 ? Whgout : Wattout, T, DM, DI};
            pg8::EpiResF32 E{ph == PH_G2 ? x : Hres, Hres, DM};
            pg8::StaticOrder S; S.init(T, DM, G, bx);
            pg8::gemm_phase<pg8::EpiResF32, pg8::StaticOrder, PG8_ALIGN, PG8_SP2>(lds, g, S, E);
        } else if (ph == PH_GATE) {
            pg8::Gemm g{U1, Wattin + (size_t)3 * QKV_COLS * DM, T, DI, DM};
            pg8::EpiGateMul E{YB, DI};
            pg8::StaticOrder S; S.init(T, DI, G, bx);
            pg8::gemm_phase<pg8::EpiGateMul, pg8::StaticOrder, PG8_ALIGN, PG8_SP2>(lds, g, S, E);
        } else if (ph == PH_NORM1) {
            for (int m = gw; m < T; m += NGW) rms_row_to_bf16(Hres + (size_t)m * DM, ln_g + DM, U1 + (size_t)m * DM, lane);
        } else if (ph == PH_FINAL) {
            for (int m = gw; m < T; m += NGW) rms_row_inplace_f32(Hres + (size_t)m * DM, (const float*)ldp(lds, 9), lane);
        }
        if (ph + 1 < ph_hi) grid.sync();
    }
}

extern "C" void kernel_launch(void* const* d_in, const int* in_sizes, int n_in, void* d_out, int out_size, void* d_ws, size_t ws_size, hipStream_t stream) {
    static int grid = 0;
    if (grid == 0) {
        if (n_in != 10 || out_size != T * DM || ws_size < WS_END) { fprintf(stderr, "kernel_launch: unexpected shapes (n_in %d out %d ws %zu)\n", n_in, out_size, ws_size); grid = -1; return; }
        int dev = 0, cus = 0, per_cu = 0;
        hipGetDevice(&dev); hipDeviceGetAttribute(&cus, hipDeviceAttributeMultiprocessorCount, dev);
        if (hipFuncSetAttribute((const void*)fwd, hipFuncAttributeMaxDynamicSharedMemorySize, LDS_BYTES) != hipSuccess) { fprintf(stderr, "kernel_launch: hipFuncSetAttribute failed\n"); grid = -1; return; }
        hipOccupancyMaxActiveBlocksPerMultiprocessor(&per_cu, (const void*)fwd, NWAVES * 64, LDS_BYTES);
        if (per_cu < 1) { fprintf(stderr, "kernel_launch: occupancy query reports %d blocks per CU\n", per_cu); per_cu = 1; }
        (void)hipGetLastError();
        grid = cus;
    }
    if (grid < 0) return;
    Args a{};
    for (int i = 0; i < 10; ++i) a.in[i] = (const float*)d_in[i];
    a.out = (float*)d_out; a.ws = (unsigned char*)d_ws;
    unsigned char* ws = (unsigned char*)d_ws;
    auto run = [&](int lo, int hi) { a.lo = lo; a.hi = hi; hipLaunchKernelGGL(fwd, dim3(grid), dim3(NWAVES * 64), LDS_BYTES, stream, a); };
    run(PH_PRO, PH_PRO + 1);
    for (int b = 0; b < 2; ++b) {
        run(PH_G1_0 + 3 * b, PH_G1_0 + 3 * b + 1);
        hipLaunchKernelGGL(naive_hgrn, dim3(16), dim3(128), 0, stream, (const bf16*)(ws + WS_BIG0), (const float*)d_in[3], (const float*)d_in[4], (bf16*)(ws + WS_BIG1) + (size_t)b * SEQ * DI);
    }
    run(PH_G2, PH_G2 + 1);
    run(PH_NORM1, PH_NORM1 + 1);
    for (int k = 0; k < 6; ++k) {
        run(PH_G3_0 + 2 * k, PH_G3_0 + 2 * k + 1);
        hipLaunchKernelGGL(naive_attn, dim3(SEQ * 16 / 256), dim3(256), 0, stream, (const bf16*)(ws + WS_QKV), (const float*)d_in[8], (bf16*)(ws + WS_BIG1) + (size_t)(k & 1) * SEQ * DI, (float*)(ws + WS_LSE) + (size_t)(k & 1) * SEQ * 16, k >> 1);
    }
    run(PH_GATE, PH_GATE + 1);
    run(PH_G5, PH_G5 + 1);
    run(PH_FINAL, PH_FINAL + 1);
}
```

```cpp
#include <hip/hip_runtime.h>
#include <hip/hip_cooperative_groups.h>
#include <cstdio>
#include <cstdint>
namespace cg = cooperative_groups;
namespace pg8 {
#define PG8_LAS __attribute__((address_space(3)))
typedef unsigned short bf16_t;
typedef short bf16x8 __attribute__((ext_vector_type(8)));
typedef float f32x4 __attribute__((ext_vector_type(4)));
typedef unsigned u32x4 __attribute__((ext_vector_type(4)));
constexpr int BM = 256, BK = 64, HALF = 128, HTB = HALF * BK * 2  , STAGE_BYTES = 8 * HTB, NXCD = 8, WGM = 8;

__host__ __device__ __forceinline__ int lds_byte(int r, int c) { const int st = (r >> 4) * 2 + (c >> 5), rr = r & 15, cc = c & 31, ob = rr * 64 + cc * 2; return st * 1024 + (ob ^ (((ob >> 9) & 1) << 5)); }
__host__ __device__ __forceinline__ void stage_rc(int b, int& R, int& C) { const int st = b / 1024, sb = b % 1024, swz = sb ^ (((sb >> 9) & 1) << 5); R = (st >> 1) * 16 + swz / 64; C = (st & 1) * 32 + (swz % 64) / 2; }
__host__ __device__ __forceinline__ int perm32(int rho) { const int n = rho >> 4, i = rho & 15; return 8 * (i >> 2) + 4 * n + (i & 3); }

struct Unit { int pm, pn; };
struct Gemm { const bf16_t* A; const bf16_t* Bt; int M, N, K; };

struct StaticOrder {
    int nM, nN, nwg, G, c;
    __host__ __device__ void init(int M, int N, int G_, int c_) { nM = M / BM; nN = N / BM; nwg = nM * nN; G = G_; c = c_; }
    __host__ __device__ bool next(int i, Unit& u) const {
        const long L = (long)i * G + c; if (L >= nwg) return false;
        int wgid = (int)L; { const int q = nwg / NXCD, r = nwg % NXCD, xcd = wgid % NXCD, off = wgid / NXCD; wgid = (xcd < r ? xcd * (q + 1) : r * (q + 1) + (xcd - r) * q) + off; }
        const int nig = WGM * nN, gid = wgid / nig, fm = gid * WGM, gsz = (nM - fm) < WGM ? (nM - fm) : WGM;
        u.pm = fm + ((wgid % nig) % gsz); u.pn = (wgid % nig) / gsz; return true;
    }
    __device__ __forceinline__ void a_ready(const Unit&) const {}
    __device__ __forceinline__ void done(const Unit&) const {}
};

__device__ __forceinline__ unsigned cvt_pk_bf16(float lo, float hi) { unsigned r; asm volatile("v_cvt_pk_bf16_f32 %0, %1, %2" : "=v"(r) : "v"(lo), "v"(hi)); return r; }
__device__ __forceinline__ float bf_lo(unsigned w) { return __uint_as_float(w << 16); }
__device__ __forceinline__ float bf_hi(unsigned w) { return __uint_as_float(w & 0xffff0000u); }
struct EpiBf16 {
    static constexpr bool PERM = true, AFTER_DRAIN = false;
    bf16_t* O; int ldc;
    __device__ __forceinline__ void operator()(const f32x4 (&acc)[2][2][4][2], const Unit& u, int wr, int wc, int fr, int fq) const {
        const int row0 = u.pm * BM + wr * 64 + fr, col0 = u.pn * BM + wc * 32 + 8 * fq;
#pragma unroll
        for (int ai = 0; ai < 2; ++ai)
#pragma unroll
            for (int m = 0; m < 4; ++m) { bf16_t* rowp = O + (size_t)(row0 + ai * HALF + m * 16) * ldc + col0;
#pragma unroll
                for (int bj = 0; bj < 2; ++bj) { const f32x4 v0 = acc[ai][bj][m][0], v1 = acc[ai][bj][m][1];
                    u32x4 w; w.x = cvt_pk_bf16(v0[0], v0[1]); w.y = cvt_pk_bf16(v0[2], v0[3]); w.z = cvt_pk_bf16(v1[0], v1[1]); w.w = cvt_pk_bf16(v1[2], v1[3]);
                    *(u32x4*)(rowp + bj * HALF) = w; } }
    }
};
struct EpiResF32 {
    static constexpr bool PERM = false, AFTER_DRAIN = false;
    const float* base; float* out; int ldc;
    __device__ __forceinline__ void operator()(const f32x4 (&acc)[2][2][4][2], const Unit& u, int wr, int wc, int fr, int fq) const {
        const int row0 = u.pm * BM + wr * 64 + fr, col0 = u.pn * BM + wc * 32 + 4 * fq;
#pragma unroll
        for (int ai = 0; ai < 2; ++ai)
#pragma unroll
            for (int m = 0; m < 4; ++m) { const size_t off = (size_t)(row0 + ai * HALF + m * 16) * ldc + col0;
#pragma unroll
                for (int bj = 0; bj < 2; ++bj)
#pragma unroll
                    for (int n = 0; n < 2; ++n) { const f32x4 b = *(const f32x4*)(base + off + bj * HALF + n * 16); *(f32x4*)(out + off + bj * HALF + n * 16) = b + acc[ai][bj][m][n]; } }
    }
};
struct EpiGateMul {
    static constexpr bool PERM = true, AFTER_DRAIN = false;
    bf16_t* O; int ldc;
    __device__ __forceinline__ float sg(float o, float g) const { return o * g / (1.0f + __expf(-g)); }
    __device__ __forceinline__ void operator()(const f32x4 (&acc)[2][2][4][2], const Unit& u, int wr, int wc, int fr, int fq) const {
        const int row0 = u.pm * BM + wr * 64 + fr, col0 = u.pn * BM + wc * 32 + 8 * fq;
#pragma unroll
        for (int ai = 0; ai < 2; ++ai)
#pragma unroll
            for (int m = 0; m < 4; ++m) { bf16_t* rowp = O + (size_t)(row0 + ai * HALF + m * 16) * ldc + col0;
#pragma unroll
                for (int bj = 0; bj < 2; ++bj) { const f32x4 v0 = acc[ai][bj][m][0], v1 = acc[ai][bj][m][1];
                    const u32x4 ov = *(const u32x4*)(rowp + bj * HALF);
                    u32x4 w; w.x = cvt_pk_bf16(sg(bf_lo(ov.x), v0[0]), sg(bf_hi(ov.x), v0[1])); w.y = cvt_pk_bf16(sg(bf_lo(ov.y), v0[2]), sg(bf_hi(ov.y), v0[3]));
                    w.z = cvt_pk_bf16(sg(bf_lo(ov.z), v1[0]), sg(bf_hi(ov.z), v1[1])); w.w = cvt_pk_bf16(sg(bf_lo(ov.w), v1[2]), sg(bf_hi(ov.w), v1[3]));
                    *(u32x4*)(rowp + bj * HALF) = w; } }
    }
};
template <class Epi, class Sched, bool ALIGN_EPI = false, bool SP2 = false>
__device__ __forceinline__ void gemm_phase(PG8_LAS unsigned char* lds, const Gemm g, const Sched& S, const Epi& E) {
    int tid_ = threadIdx.x; asm volatile("" : "+v"(tid_));
    const int tid = tid_, wid = __builtin_amdgcn_readfirstlane(tid >> 6), lane = tid & 63, wr = wid >> 2, wc = wid & 3, fr = lane & 15, fq = lane >> 4;
    const int K = g.K, nt = K / BK;
    unsigned voffA[2], voffB[2];
#pragma unroll
    for (int i = 0; i < 2; ++i) { int R, C; stage_rc(tid * 16 + i * 8192, R, C); const int Rb = Epi::PERM ? ((R & ~31) + perm32(R & 31)) : R;
        voffA[i] = (unsigned)(R * K + C) * 2u; voffB[i] = (unsigned)(Rb * K + C) * 2u; }
    const size_t kstep = (size_t)(BK * 2);
    const size_t hstep = (size_t)HALF * K * 2;
    const size_t tstep = 2 * hstep;
    const unsigned ldsw = (unsigned)wid * 1024u;
    const int aoff = lds_byte(wr * 64 + fr, fq * 8), boff = lds_byte(wc * 32 + fr, fq * 8);
#define PG8_SA(b, h) (((b) * 2 + (h)) * HTB)
#define PG8_SB(b, h) ((4 + (b) * 2 + (h)) * HTB)
#define PG8_STAGE(bufoff, gbase, voff) do { _Pragma("unroll") for (int _i = 0; _i < 2; ++_i) \
        __builtin_amdgcn_global_load_lds((const unsigned*)((const char*)(gbase) + (voff)[_i]), (PG8_LAS unsigned*)(lds + (bufoff) + ldsw + _i * 8192), 16, 0, 0); } while (0)
#define PG8_LDA(dst, b, h) do { _Pragma("unroll") for (int m = 0; m < 4; ++m) _Pragma("unroll") for (int k = 0; k < 2; ++k) dst[m][k] = *(const PG8_LAS bf16x8*)(lds + PG8_SA(b, h) + aoff + m * 2048 + k * 1024); } while (0)
#define PG8_LDB(dst, b, h) do { _Pragma("unroll") for (int n = 0; n < 2; ++n) _Pragma("unroll") for (int k = 0; k < 2; ++k) dst[n][k] = *(const PG8_LAS bf16x8*)(lds + PG8_SB(b, h) + boff + n * 2048 + k * 1024); } while (0)
#define PG8_MMA(ai, bj, At, Bt) do { __builtin_amdgcn_s_setprio(1); _Pragma("unroll") for (int m = 0; m < 4; ++m) _Pragma("unroll") for (int n = 0; n < 2; ++n) _Pragma("unroll") for (int k = 0; k < 2; ++k) \
        acc[ai][bj][m][n] = __builtin_amdgcn_mfma_f32_16x16x32_bf16(Bt[n][k], At[m][k], acc[ai][bj][m][n], 0, 0, 0); __builtin_amdgcn_s_setprio(0); } while (0)
#define PG8_WAIT_V(n) asm volatile("s_waitcnt vmcnt(" #n ")" ::: "memory")
#define PG8_WAIT_L(n) asm volatile("s_waitcnt lgkmcnt(" #n ")" ::: "memory")
#define PG8_BAR __builtin_amdgcn_s_barrier()
#define PG8_SCHED __builtin_amdgcn_sched_barrier(0)
    Unit cur, nxt; int ui = 0;
    if (!S.next(0, cur)) return;
    f32x4 acc[2][2][4][2];
#pragma unroll
    for (int a = 0; a < 2; ++a)
#pragma unroll
        for (int b = 0; b < 2; ++b)
#pragma unroll
            for (int m = 0; m < 4; ++m)
#pragma unroll
                for (int n = 0; n < 2; ++n) acc[a][b][m][n] = (f32x4){0.f, 0.f, 0.f, 0.f};
    bf16x8 At[4][2], B0[2][2], B1[2][2];
    const char* cA = (const char*)g.A + (size_t)cur.pm * tstep; const char* cB = (const char*)g.Bt + (size_t)cur.pn * tstep;
    S.a_ready(cur);
    if constexpr (SP2) {
        PG8_STAGE(PG8_SB(0, 0), cB, voffB); PG8_STAGE(PG8_SB(0, 1), cB + hstep, voffB); PG8_STAGE(PG8_SA(0, 0), cA, voffA); PG8_STAGE(PG8_SA(0, 1), cA + hstep, voffA);
        if (wr == 1) PG8_BAR;
        PG8_WAIT_V(2); PG8_BAR;
        PG8_STAGE(PG8_SB(1, 0), cB + kstep, voffB); PG8_STAGE(PG8_SA(1, 0), cA + kstep, voffA); PG8_STAGE(PG8_SB(1, 1), cB + hstep + kstep, voffB);
        PG8_WAIT_V(6); PG8_BAR;
    } else {
        PG8_STAGE(PG8_SB(0, 0), cB, voffB); PG8_STAGE(PG8_SA(0, 0), cA, voffA); PG8_STAGE(PG8_SB(0, 1), cB + hstep, voffB); PG8_STAGE(PG8_SA(0, 1), cA + hstep, voffA);
        if (wr == 1) PG8_BAR;
        PG8_WAIT_V(4); PG8_BAR;
        PG8_STAGE(PG8_SB(1, 0), cB + kstep, voffB); PG8_STAGE(PG8_SA(1, 0), cA + kstep, voffA); PG8_STAGE(PG8_SB(1, 1), cB + hstep + kstep, voffB);
        PG8_WAIT_V(6); PG8_BAR;
    }
    for (;;) {
        const bool has_next = S.next(ui + 1, nxt);
        const char* nA = has_next ? (const char*)g.A + (size_t)nxt.pm * tstep : cA; const char* nB = has_next ? (const char*)g.Bt + (size_t)nxt.pn * tstep : cB;
        for (int t = 0; t < nt; t += 2) {
            const bool last = (t == nt - 2);
            const char* a1 = cA + (size_t)(t + 1) * kstep;
            const char* a2 = last ? nA : cA + (size_t)(t + 2) * kstep; const char* b2 = last ? nB : cB + (size_t)(t + 2) * kstep;
            const char* a3 = a2 + kstep; const char* b3 = b2 + kstep;
            if (last && has_next) S.a_ready(nxt);
            if constexpr (SP2) {
            PG8_LDB(B0, 0, 0); PG8_LDB(B1, 0, 1); PG8_SCHED; PG8_LDA(At, 0, 0); PG8_STAGE(PG8_SA(1, 1), a1 + hstep, voffA);
            PG8_WAIT_V(8); PG8_WAIT_L(0); PG8_BAR; PG8_MMA(0, 0, At, B0); PG8_MMA(0, 1, At, B1); PG8_BAR; PG8_SCHED;
            PG8_LDA(At, 0, 1); PG8_STAGE(PG8_SB(0, 0), b2, voffB); PG8_STAGE(PG8_SB(0, 1), b2 + hstep, voffB); PG8_STAGE(PG8_SA(0, 0), a2, voffA);
            PG8_WAIT_V(8); PG8_WAIT_L(0); PG8_BAR; PG8_MMA(1, 0, At, B0); PG8_MMA(1, 1, At, B1); PG8_BAR; PG8_SCHED;
            PG8_LDB(B0, 1, 0); PG8_LDB(B1, 1, 1); PG8_SCHED; PG8_LDA(At, 1, 0); PG8_STAGE(PG8_SA(0, 1), a2 + hstep, voffA);
            PG8_WAIT_V(8); PG8_WAIT_L(0); PG8_BAR; PG8_MMA(0, 0, At, B0); PG8_MMA(0, 1, At, B1); PG8_BAR; PG8_SCHED;
            PG8_LDA(At, 1, 1); PG8_STAGE(PG8_SB(1, 0), b3, voffB); PG8_STAGE(PG8_SB(1, 1), b3 + hstep, voffB); PG8_STAGE(PG8_SA(1, 0), a3, voffA);
            PG8_WAIT_V(8); PG8_WAIT_L(0); PG8_BAR; PG8_MMA(1, 0, At, B0); PG8_MMA(1, 1, At, B1); PG8_BAR; PG8_SCHED;
            } else {
            PG8_LDB(B0, 0, 0); PG8_SCHED; PG8_LDA(At, 0, 0); PG8_STAGE(PG8_SA(1, 1), a1 + hstep, voffA);
            PG8_WAIT_L(8); PG8_BAR; PG8_WAIT_L(0); PG8_MMA(0, 0, At, B0); PG8_BAR; PG8_SCHED;
            PG8_LDB(B1, 0, 1); PG8_STAGE(PG8_SB(0, 0), b2, voffB);
            PG8_BAR; PG8_WAIT_L(0); PG8_MMA(0, 1, At, B1); PG8_BAR;
            PG8_LDA(At, 0, 1); PG8_STAGE(PG8_SA(0, 0), a2, voffA);
            PG8_BAR; PG8_WAIT_L(0); PG8_MMA(1, 0, At, B0); PG8_BAR; PG8_SCHED;
            PG8_STAGE(PG8_SB(0, 1), b2 + hstep, voffB);
            PG8_WAIT_V(6); PG8_BAR; PG8_MMA(1, 1, At, B1); PG8_BAR;
            PG8_LDB(B0, 1, 0); PG8_SCHED; PG8_LDA(At, 1, 0); PG8_STAGE(PG8_SA(0, 1), a2 + hstep, voffA);
            PG8_WAIT_L(8); PG8_BAR; PG8_WAIT_L(0); PG8_MMA(0, 0, At, B0); PG8_BAR; PG8_SCHED;
            PG8_LDB(B1, 1, 1); PG8_STAGE(PG8_SB(1, 0), b3, voffB);
            PG8_BAR; PG8_WAIT_L(0); PG8_MMA(0, 1, At, B1); PG8_BAR;
            PG8_LDA(At, 1, 1); PG8_STAGE(PG8_SA(1, 0), a3, voffA);
            PG8_BAR; PG8_WAIT_L(0); PG8_MMA(1, 0, At, B0); PG8_BAR; PG8_SCHED;
            PG8_STAGE(PG8_SB(1, 1), b3 + hstep, voffB);
            PG8_WAIT_V(6); PG8_BAR; PG8_MMA(1, 1, At, B1); PG8_BAR;
            }
        }
        if constexpr (ALIGN_EPI) { if (wr == 0) PG8_BAR; }
        if constexpr (!Epi::AFTER_DRAIN) { E(acc, cur, wr, wc, fr, fq); S.done(cur); }
        if (!has_next) break;
#pragma unroll
        for (int a = 0; a < 2; ++a)
#pragma unroll
            for (int b = 0; b < 2; ++b)
#pragma unroll
                for (int m = 0; m < 4; ++m)
#pragma unroll
                    for (int n = 0; n < 2; ++n) acc[a][b][m][n] = (f32x4){0.f, 0.f, 0.f, 0.f};
        cur = nxt; cA = nA; cB = nB; ++ui;
        if constexpr (ALIGN_EPI) { if (wr == 1) PG8_BAR; }
    }
    PG8_WAIT_V(0);
    if constexpr (!ALIGN_EPI) { if (wr == 0) PG8_BAR; }
    PG8_BAR;
    if constexpr (Epi::AFTER_DRAIN) { E.fused(acc, cur, wr, wc, fr, fq, lds, wid, lane); S.done(cur); }
#undef PG8_SA
#undef PG8_SB
#undef PG8_STAGE
#undef PG8_LDA
#undef PG8_LDB
#undef PG8_MMA
#undef PG8_WAIT_V
#undef PG8_WAIT_L
#undef PG8_BAR
#undef PG8_SCHED
}
}
#ifndef PG8_SP2
#define PG8_SP2 true
#endif
#ifndef PG8_ALIGN
#define PG8_ALIGN true
#endif
constexpr int NWAVES = 8;
constexpr int BATCH = 2, SEQ = 16384, DM = 1024, DI = 2048, T = BATCH * SEQ;
constexpr int HG_COLS = 4 * DI;
constexpr int ATT_COLS = 10 * DI;
constexpr int QKV_COLS = 3 * DI;
constexpr float EPS = 1e-6f;
constexpr size_t MiB = 1u << 20;
constexpr size_t WS_CTL = 0;
constexpr size_t WS_WHGIN = 1 * MiB, WS_WHGOUT = 17 * MiB, WS_WATTIN = 21 * MiB, WS_WATTOUT = 61 * MiB;
constexpr size_t WS_LSE = 65 * MiB;
constexpr size_t WS_BIG0 = 96 * MiB;
constexpr size_t WS_U1 = WS_BIG0, WS_QKV = WS_BIG0 + 64 * MiB;
constexpr size_t WS_BIG1 = 352 * MiB;
constexpr size_t WS_END = 480 * MiB;
constexpr int RING_BYTES = 131072;
constexpr int LDS_BYTES = 147456;
enum { PH_PRO = 0, PH_G1_0 = 1, PH_HGA_0 = 2, PH_HGB_0 = 3, PH_G1_1 = 4, PH_HGA_1 = 5, PH_HGB_1 = 6, PH_G2 = 7, PH_NORM1 = 8, PH_G3_0 = 9  , PH_GATE = 21, PH_G5 = 22, PH_FINAL = 23, PH_END = 24 };

#define LAS __attribute__((address_space(3)))
typedef unsigned short bf16;
typedef unsigned v4u __attribute__((ext_vector_type(4)));
typedef float f32x4 __attribute__((ext_vector_type(4)));
#define LDS_WAIT() asm volatile("s_waitcnt lgkmcnt(0)" ::: "memory")
__device__ __forceinline__ unsigned f2bf(float f) { unsigned u = __builtin_bit_cast(unsigned, f); return (u + 0x7fffu + ((u >> 16) & 1u)) >> 16; }
__device__ __forceinline__ unsigned pk2(float lo, float hi) { return f2bf(lo) | (f2bf(hi) << 16); }
__device__ __forceinline__ float bf2f(unsigned short b) { return __uint_as_float(((unsigned)b) << 16); }
__device__ __forceinline__ float blo(unsigned w) { return __uint_as_float(w << 16); }
__device__ __forceinline__ float bhi(unsigned w) { return __uint_as_float(w & 0xffff0000u); }
__device__ __forceinline__ float wave_sum(float v) {
#pragma unroll
    for (int o = 1; o < 64; o <<= 1) v += __shfl_xor(v, o);
    return v;
}
__device__ const unsigned char BUCKET[3][129] = {
{0,1,2,3,4,5,6,7,8,9,10,11,12,13,14,15,16,16,16,16,16,16,17,17,17,17,17,17,17,17,18,18,18,18,18,18,18,18,18,18,19,19,19,19,19,19,19,19,19,19,19,19,19,19,20,20,20,20,20,20,20,20,20,20,20,20,20,20,20,20,20,20,20,21,21,21,21,21,21,21,21,21,21,21,21,21,21,21,21,21,21,21,21,21,21,21,21,21,21,22,22,22,22,22,22,22,22,22,22,22,22,22,22,22,22,22,22,22,22,22,22,22,22,22,22,22,22,22,22},
{0,4,8,12,16,16,17,17,18,18,19,19,19,19,20,20,20,20,20,21,21,21,21,21,21,22,22,22,22,22,22,22,22,22,23,23,23,23,23,23,23,23,23,23,23,23,24,24,24,24,24,24,24,24,24,24,24,24,24,24,24,24,25,25,25,25,25,25,25,25,25,25,25,25,25,25,25,25,25,25,25,25,25,26,26,26,26,26,26,26,26,26,26,26,26,26,26,26,26,26,26,26,26,26,26,26,26,26,26,26,26,26,26,27,27,27,27,27,27,27,27,27,27,27,27,27,27,27,27},
{0,16,18,19,20,21,21,22,22,23,23,23,24,24,24,24,25,25,25,25,25,26,26,26,26,26,26,26,26,27,27,27,27,27,27,27,27,27,27,28,28,28,28,28,28,28,28,28,28,28,28,28,29,29,29,29,29,29,29,29,29,29,29,29,29,29,29,29,29,29,30,30,30,30,30,30,30,30,30,30,30,30,30,30,30,30,30,30,30,30,30,30,30,30,30,31,31,31,31,31,31,31,31,31,31,31,31,31,31,31,31,31,31,31,31,31,31,31,31,31,31,31,31,31,31,31,31,31,31}};

__device__ __forceinline__ void p0_transpose_item(const float* W, int K, int N, bf16* WT, LAS float* scr, int item, int lane) {
    const int nblk = N / 32, kb = item / nblk, nb = item % nblk, k0 = 64 * kb, n0 = 32 * nb;
#pragma unroll 8
    for (int i = 0; i < 32; ++i) { const int kk = 2 * i + (lane >> 5); scr[kk * 33 + (lane & 31)] = W[(size_t)(k0 + kk) * N + n0 + (lane & 31)]; }
    LDS_WAIT(); asm volatile("" ::: "memory");
    const int c = lane & 7;
#pragma unroll
    for (int j = 0; j < 4; ++j) { const int n = (lane >> 3) + 8 * j; const LAS float* s = scr + (8 * c) * 33 + n;
        v4u o; o.x = pk2(s[0 * 33], s[1 * 33]); o.y = pk2(s[2 * 33], s[3 * 33]); o.z = pk2(s[4 * 33], s[5 * 33]); o.w = pk2(s[6 * 33], s[7 * 33]);
        *(v4u*)(WT + (size_t)(n0 + n) * K + k0 + 8 * c) = o; }
    LDS_WAIT(); asm volatile("" ::: "memory");
}
__device__ __forceinline__ void rms_row_to_bf16(const float* xrow, const float* g, bf16* orow, int lane) {
    const f32x4* xr = (const f32x4*)xrow + lane; const f32x4* gr = (const f32x4*)g + lane;
    f32x4 v[4]; float s = 0.f;
#pragma unroll
    for (int j = 0; j < 4; ++j) { v[j] = xr[64 * j]; s += (v[j].x * v[j].x + v[j].y * v[j].y) + (v[j].z * v[j].z + v[j].w * v[j].w); }
    const float rs = 1.0f / sqrtf(wave_sum(s) * (1.0f / DM) + EPS);
    unsigned long long* o8 = (unsigned long long*)orow + lane;
#pragma unroll
    for (int j = 0; j < 4; ++j) { const f32x4 gv = gr[64 * j]; const f32x4 o = v[j] * rs * gv;
        o8[64 * j] = (unsigned long long)pk2(o.x, o.y) | ((unsigned long long)pk2(o.z, o.w) << 32); }
}
__device__ __forceinline__ void rms_row_inplace_f32(float* xrow, const float* g, int lane) {
    f32x4* xr = (f32x4*)xrow + lane; const f32x4* gr = (const f32x4*)g + lane;
    f32x4 v[4]; float s = 0.f;
#pragma unroll
    for (int j = 0; j < 4; ++j) { v[j] = xr[64 * j]; s += (v[j].x * v[j].x + v[j].y * v[j].y) + (v[j].z * v[j].z + v[j].w * v[j].w); }
    const float rs = 1.0f / sqrtf(wave_sum(s) * (1.0f / DM) + EPS);
#pragma unroll
    for (int j = 0; j < 4; ++j) { const f32x4 gv = gr[64 * j]; xr[64 * j] = v[j] * rs * gv; }
}

__device__ __forceinline__ void naive_hgrn(LAS unsigned char* lds, int h, int e, bool active, const bf16* __restrict__ qfig, const float* __restrict__ lb_logits, const float* __restrict__ norm_g, bf16* __restrict__ y) {
    const int col = h * 128 + e;
    LAS float* sq = (LAS float*)lds; LAS float* sf = sq + 16 * 128; LAS float* sv = sf + 16 * 128; LAS float* so = sv + 16 * 128;
    float S[128];
#pragma unroll
    for (int d = 0; d < 128; ++d) S[d] = 0.f;
    float lb = 0.f;
    if (active) { const float l0 = lb_logits[col], l1 = lb_logits[DI + col], l2 = lb_logits[2 * DI + col];
        const float mx = fmaxf(l0, fmaxf(l1, l2)); const float e0 = expf(l0 - mx), e1 = expf(l1 - mx), e2 = expf(l2 - mx);
        lb = e0 / (e0 + e1 + e2); }
    for (int t0 = 0; t0 < SEQ; t0 += 16) {
        if (active) for (int c = 0; c < 16; ++c) { const bf16* row = qfig + (size_t)(t0 + c) * HG_COLS + col;
            sq[c * 128 + e] = bf2f(row[0]); const float fp = bf2f(row[DI]); sf[c * 128 + e] = lb + (1.f - lb) / (1.f + expf(-fp)); sv[c * 128 + e] = bf2f(row[2 * DI]); }
        __syncthreads();
        if (active) for (int c = 0; c < 16; ++c) { const float v = sv[c * 128 + e]; float o = 0.f;
#pragma unroll
            for (int d = 0; d < 128; ++d) { const float f = sf[c * 128 + d]; S[d] = f * S[d] + (1.f - f) * v; o += sq[c * 128 + d] * S[d]; }
            so[c * 128 + e] = o; }
        __syncthreads();
        if (active) { const int w = e >> 6, lane = e & 63;
        for (int cc = 0; cc < 8; ++cc) { const int c = w * 8 + cc; const float a = so[c * 128 + lane], b2 = so[c * 128 + lane + 64];
            const float ss = wave_sum(a * a + b2 * b2);
            const float rs = 1.0f / sqrtf(ss * (1.0f / 128.0f) + EPS);
            const bf16* grow = qfig + (size_t)(t0 + c) * HG_COLS + 3 * DI + h * 128;
            bf16* yrow = y + (size_t)(t0 + c) * DI + h * 128;
            for (int k = 0; k < 2; ++k) { const int ee = lane + 64 * k; const float g = bf2f(grow[ee]); const float ov = (k ? b2 : a) * rs * norm_g[h * 128 + ee];
                yrow[ee] = (bf16)f2bf(ov * g / (1.f + expf(-g))); } } }
        __syncthreads();
    }
}
__device__ __forceinline__ void naive_attn(int idx, const bf16* __restrict__ qkv, const float* __restrict__ rel_bias, bf16* __restrict__ oacc, float* __restrict__ lseacc, int g) {
    const int h = idx & 15, t = idx >> 4;
    const int dil = g == 0 ? 1 : (g == 1 ? 4 : 16);
    const v4u* qp = (const v4u*)(qkv + (size_t)t * QKV_COLS + h * 128);
    float la = 0.f; if (g > 0) la = lseacc[t * 16 + h];
    float ln = 0.f;
    for (int half = 0; half < 2; ++half) {
        float o[64];
#pragma unroll
        for (int i = 0; i < 64; ++i) o[i] = 0.f;
        float m = -1e30f, l = 0.f;
        for (int j = 0; j <= 128; ++j) { const int tk = t - j * dil; if (tk < 0) break;
            const v4u* kp = (const v4u*)(qkv + (size_t)tk * QKV_COLS + DI + h * 128);
            const v4u* vp = (const v4u*)(qkv + (size_t)tk * QKV_COLS + 2 * DI + h * 128 + half * 64);
            float s = 0.f;
#pragma unroll
            for (int i = 0; i < 16; ++i) { const v4u a = qp[i], b = kp[i];
                s += blo(a.x) * blo(b.x) + bhi(a.x) * bhi(b.x) + blo(a.y) * blo(b.y) + bhi(a.y) * bhi(b.y) + blo(a.z) * blo(b.z) + bhi(a.z) * bhi(b.z) + blo(a.w) * blo(b.w) + bhi(a.w) * bhi(b.w); }
            s = s * 0.08838834764831845f + rel_bias[(int)BUCKET[g][j] * 48 + g * 16 + h];
            const float mn = fmaxf(m, s); const float alpha = expf(m - mn), p = expf(s - mn);
            l = l * alpha + p; m = mn;
#pragma unroll
            for (int i = 0; i < 8; ++i) { const v4u b = vp[i];
                o[8 * i + 0] = o[8 * i + 0] * alpha + p * blo(b.x); o[8 * i + 1] = o[8 * i + 1] * alpha + p * bhi(b.x);
                o[8 * i + 2] = o[8 * i + 2] * alpha + p * blo(b.y); o[8 * i + 3] = o[8 * i + 3] * alpha + p * bhi(b.y);
                o[8 * i + 4] = o[8 * i + 4] * alpha + p * blo(b.z); o[8 * i + 5] = o[8 * i + 5] * alpha + p * bhi(b.z);
                o[8 * i + 6] = o[8 * i + 6] * alpha + p * blo(b.w); o[8 * i + 7] = o[8 * i + 7] * alpha + p * bhi(b.w); }
        }
        const float lse = m + logf(l);
        float wa = 0.f, wg = 1.0f / l; ln = lse;
        v4u* op = (v4u*)(oacc + (size_t)t * DI + h * 128 + half * 64);
        if (g > 0) { const float mm = fmaxf(la, lse); ln = mm + logf(expf(la - mm) + expf(lse - mm)); wa = expf(la - ln); wg = expf(lse - ln) / l; }
#pragma unroll
        for (int i = 0; i < 8; ++i) { v4u a = (v4u){0u, 0u, 0u, 0u}; if (g > 0) a = op[i];
            v4u r; r.x = pk2(wa * blo(a.x) + wg * o[8 * i + 0], wa * bhi(a.x) + wg * o[8 * i + 1]); r.y = pk2(wa * blo(a.y) + wg * o[8 * i + 2], wa * bhi(a.y) + wg * o[8 * i + 3]);
            r.z = pk2(wa * blo(a.z) + wg * o[8 * i + 4], wa * bhi(a.z) + wg * o[8 * i + 5]); r.w = pk2(wa * blo(a.w) + wg * o[8 * i + 6], wa * bhi(a.w) + wg * o[8 * i + 7]);
            op[i] = r; }
    }
    lseacc[t * 16 + h] = ln;
}

__device__ __forceinline__ const void* ldp(LAS unsigned char* lds, int i) {
    const unsigned long long v = ((LAS unsigned long long*)(lds + RING_BYTES))[i];
    const unsigned lo = __builtin_amdgcn_readfirstlane((unsigned)v), hi = __builtin_amdgcn_readfirstlane((unsigned)(v >> 32));
    return (const void*)(((unsigned long long)hi << 32) | lo);
}
struct Args { const float* in[10]; float* out; unsigned char* ws; int lo, hi; };
__global__ void __launch_bounds__(NWAVES * 64, 2) fwd(Args args) {
    extern __shared__ __attribute__((aligned(16))) unsigned char lds_raw[];
    LAS unsigned char* lds = (LAS unsigned char*)lds_raw;
    cg::grid_group grid = cg::this_grid();
    const int tid0 = threadIdx.x;
    const int G = gridDim.x; const int bx = blockIdx.x;
    const int vcu = (G % 8 == 0) ? (bx % 8) * (G / 8) + bx / 8 : bx;
    const int NGW = G * NWAVES;
    { LAS unsigned long long* P = (LAS unsigned long long*)(lds + RING_BYTES);
      if (tid0 < 10) P[tid0] = (unsigned long long)args.in[tid0];
      if (tid0 == 10) P[10] = (unsigned long long)args.out;
      if (tid0 == 11) P[11] = (unsigned long long)args.ws;
      __syncthreads(); }
    const int ph_hi = args.hi;
    for (int ph = args.lo; ph < ph_hi; ++ph) {
        int tid = threadIdx.x; asm volatile("" : "+v"(tid) :: "memory");
        const int lane = tid & 63, wave = __builtin_amdgcn_readfirstlane(tid >> 6), gw = vcu * NWAVES + wave;
        const float* x = (const float*)ldp(lds, 0); const float* ln_g = (const float*)ldp(lds, 1);
        unsigned char* ws = (unsigned char*)ldp(lds, 11); float* Hres = (float*)ldp(lds, 10); bf16* U0 = (bf16*)Hres;
        bf16* Whgin = (bf16*)(ws + WS_WHGIN); bf16* Whgout = (bf16*)(ws + WS_WHGOUT); bf16* Wattin = (bf16*)(ws + WS_WATTIN); bf16* Wattout = (bf16*)(ws + WS_WATTOUT);
        bf16* QFIG = (bf16*)(ws + WS_BIG0); bf16* U1 = (bf16*)(ws + WS_U1); bf16* QKV = (bf16*)(ws + WS_QKV); bf16* YB = (bf16*)(ws + WS_BIG1);
        if (ph == PH_PRO) {
            LAS float* scr = (LAS float*)(lds + wave * 16384);
            const float* hg_w_in = (const float*)ldp(lds, 2); const float* hg_w_out = (const float*)ldp(lds, 5); const float* att_w_in = (const float*)ldp(lds, 6); const float* att_w_out = (const float*)ldp(lds, 7);
            constexpr int I_A = (DM / 64) * (HG_COLS / 32), I_B = (DI / 64) * (DM / 32), I_C = (DM / 64) * (ATT_COLS / 32), I_D = I_B;
            for (int it = gw; it < I_A + I_B + I_C + I_D; it += NGW) {
                int r = it;
                if (r < I_A) { p0_transpose_item(hg_w_in, DM, HG_COLS, Whgin, scr, r, lane); continue; } r -= I_A;
                if (r < I_B) { p0_transpose_item(hg_w_out, DI, DM, Whgout, scr, r, lane); continue; } r -= I_B;
                if (r < I_C) { p0_transpose_item(att_w_in, DM, ATT_COLS, Wattin, scr, r, lane); continue; } r -= I_C;
                p0_transpose_item(att_w_out, DI, DM, Wattout, scr, r, lane);
            }
            for (int m = gw; m < T; m += NGW) rms_row_to_bf16(x + (size_t)m * DM, ln_g, U0 + (size_t)m * DM, lane);
        } else if (ph == PH_G1_0 || ph == PH_G1_1) {
            const int b = (ph == PH_G1_1);
            const pg8::Gemm g{U0 + (size_t)b * SEQ * DM, Whgin, SEQ, HG_COLS, DM}; const pg8::EpiBf16 E{QFIG, HG_COLS};
            pg8::StaticOrder S; S.init(SEQ, HG_COLS, G, bx);
            pg8::gemm_phase<pg8::EpiBf16, pg8::StaticOrder, PG8_ALIGN, PG8_SP2>(lds, g, S, E);
        } else if (ph >= PH_G3_0 && ph < PH_GATE && ((ph - PH_G3_0) & 1) == 0) {
            const int k = (ph - PH_G3_0) >> 1, gi = k >> 1, b = k & 1;
            const pg8::Gemm g{U1 + (size_t)b * SEQ * DM, Wattin + (size_t)gi * QKV_COLS * DM, SEQ, QKV_COLS, DM}; const pg8::EpiBf16 E{QKV, QKV_COLS};
            pg8::StaticOrder S; S.init(SEQ, QKV_COLS, G, bx);
            pg8::gemm_phase<pg8::EpiBf16, pg8::StaticOrder, PG8_ALIGN, PG8_SP2>(lds, g, S, E);
        } else if (ph == PH_G2 || ph == PH_G5) {
            pg8::Gemm g{YB, ph == PH_G2 ? Whgout : Wattout, T, DM, DI};
            pg8::EpiResF32 E{ph == PH_G2 ? x : Hres, Hres, DM};
            pg8::StaticOrder S; S.init(T, DM, G, bx);
            pg8::gemm_phase<pg8::EpiResF32, pg8::StaticOrder, PG8_ALIGN, PG8_SP2>(lds, g, S, E);
        } else if (ph == PH_GATE) {
            pg8::Gemm g{U1, Wattin + (size_t)3 * QKV_COLS * DM, T, DI, DM};
            pg8::EpiGateMul E{YB, DI};
            pg8::StaticOrder S; S.init(T, DI, G, bx);
            pg8::gemm_phase<pg8::EpiGateMul, pg8::StaticOrder, PG8_ALIGN, PG8_SP2>(lds, g, S, E);
        } else if (ph == PH_HGA_0 || ph == PH_HGA_1) {
            const int b = (ph == PH_HGA_1);
            if (vcu < 16) naive_hgrn(lds, vcu, tid & 127, tid < 128, QFIG, (const float*)ldp(lds, 3), (const float*)ldp(lds, 4), YB + (size_t)b * SEQ * DI);
        } else if (ph >= PH_G3_0 && ph < PH_GATE && ((ph - PH_G3_0) & 1) == 1) {
            const int k = (ph - PH_G3_0) >> 1, gi = k >> 1, b = k & 1;
            for (int idx = bx * (NWAVES * 64) + tid; idx < SEQ * 16; idx += G * NWAVES * 64)
                naive_attn(idx, QKV, (const float*)ldp(lds, 8), YB + (size_t)b * SEQ * DI, (float*)(ws + WS_LSE) + (size_t)b * SEQ * 16, gi);
        } else if (ph == PH_NORM1) {
            for (int m = gw; m < T; m += NGW) rms_row_to_bf16(Hres + (size_t)m * DM, ln_g + DM, U1 + (size_t)m * DM, lane);
        } else if (ph == PH_FINAL) {
            for (int m = gw; m < T; m += NGW) rms_row_inplace_f32(Hres + (size_t)m * DM, (const float*)ldp(lds, 9), lane);
        }
        if (ph + 1 < ph_hi) grid.sync();
    }
}

extern "C" void kernel_launch(void* const* d_in, const int* in_sizes, int n_in, void* d_out, int out_size, void* d_ws, size_t ws_size, hipStream_t stream) {
    static int grid = 0;
    if (grid == 0) {
        if (n_in != 10 || out_size != T * DM || ws_size < WS_END) { fprintf(stderr, "kernel_launch: unexpected shapes (n_in %d out %d ws %zu)\n", n_in, out_size, ws_size); grid = -1; return; }
        int dev = 0, cus = 0, per_cu = 0;
        hipGetDevice(&dev); hipDeviceGetAttribute(&cus, hipDeviceAttributeMultiprocessorCount, dev);
        if (hipFuncSetAttribute((const void*)fwd, hipFuncAttributeMaxDynamicSharedMemorySize, LDS_BYTES) != hipSuccess) { fprintf(stderr, "kernel_launch: hipFuncSetAttribute failed\n"); grid = -1; return; }
        hipOccupancyMaxActiveBlocksPerMultiprocessor(&per_cu, (const void*)fwd, NWAVES * 64, LDS_BYTES);
        if (per_cu < 1) { fprintf(stderr, "kernel_launch: occupancy query reports %d blocks per CU\n", per_cu); per_cu = 1; }
        (void)hipGetLastError();
        grid = cus * per_cu;
    }
    if (grid < 0) return;
    Args a{};
    for (int i = 0; i < 10; ++i) a.in[i] = (const float*)d_in[i];
    a.out = (float*)d_out; a.ws = (unsigned char*)d_ws;
    a.lo = PH_PRO; a.hi = PH_END;
    void* kargs[] = {&a};
    const hipError_t le = hipLaunchCooperativeKernel((const void*)fwd, dim3(grid), dim3(NWAVES * 64), kargs, LDS_BYTES, stream);
    if (le != hipSuccess) fprintf(stderr, "kernel_launch: cooperative launch failed: %s (grid %d)\n", hipGetErrorString(le), grid);
}
```

```cpp
#include <hip/hip_runtime.h>
#include <hip/hip_cooperative_groups.h>
#include <cstdio>
#include <cstdint>
namespace cg = cooperative_groups;
namespace pg8 {
#define PG8_LAS __attribute__((address_space(3)))
typedef unsigned short bf16_t;
typedef short bf16x8 __attribute__((ext_vector_type(8)));
typedef float f32x4 __attribute__((ext_vector_type(4)));
typedef unsigned u32x4 __attribute__((ext_vector_type(4)));
constexpr int BM = 256, BK = 64, HALF = 128, HTB = HALF * BK * 2  , STAGE_BYTES = 8 * HTB, NXCD = 8, WGM = 8;

__host__ __device__ __forceinline__ int lds_byte(int r, int c) { const int st = (r >> 4) * 2 + (c >> 5), rr = r & 15, cc = c & 31, ob = rr * 64 + cc * 2; return st * 1024 + (ob ^ (((ob >> 9) & 1) << 5)); }
__host__ __device__ __forceinline__ void stage_rc(int b, int& R, int& C) { const int st = b / 1024, sb = b % 1024, swz = sb ^ (((sb >> 9) & 1) << 5); R = (st >> 1) * 16 + swz / 64; C = (st & 1) * 32 + (swz % 64) / 2; }
__host__ __device__ __forceinline__ int perm32(int rho) { const int n = rho >> 4, i = rho & 15; return 8 * (i >> 2) + 4 * n + (i & 3); }

struct Unit { int pm, pn; };
struct Gemm { const bf16_t* A; const bf16_t* Bt; int M, N, K; };

struct StaticOrder {
    int nM, nN, nwg, G, c;
    __host__ __device__ void init(int M, int N, int G_, int c_) { nM = M / BM; nN = N / BM; nwg = nM * nN; G = G_; c = c_; }
    __host__ __device__ bool next(int i, Unit& u) const {
        const long L = (long)i * G + c; if (L >= nwg) return false;
        int wgid = (int)L; { const int q = nwg / NXCD, r = nwg % NXCD, xcd = wgid % NXCD, off = wgid / NXCD; wgid = (xcd < r ? xcd * (q + 1) : r * (q + 1) + (xcd - r) * q) + off; }
        const int nig = WGM * nN, gid = wgid / nig, fm = gid * WGM, gsz = (nM - fm) < WGM ? (nM - fm) : WGM;
        u.pm = fm + ((wgid % nig) % gsz); u.pn = (wgid % nig) / gsz; return true;
    }
    __device__ __forceinline__ void a_ready(const Unit&) const {}
    __device__ __forceinline__ void done(const Unit&) const {}
};

__device__ __forceinline__ unsigned cvt_pk_bf16(float lo, float hi) { unsigned r; asm volatile("v_cvt_pk_bf16_f32 %0, %1, %2" : "=v"(r) : "v"(lo), "v"(hi)); return r; }
__device__ __forceinline__ float bf_lo(unsigned w) { return __uint_as_float(w << 16); }
__device__ __forceinline__ float bf_hi(unsigned w) { return __uint_as_float(w & 0xffff0000u); }
struct EpiBf16 {
    static constexpr bool PERM = true, AFTER_DRAIN = false;
    bf16_t* O; int ldc; int qcols; float qscale;
    __device__ __forceinline__ void operator()(const f32x4 (&acc)[2][2][4][2], const Unit& u, int wr, int wc, int fr, int fq) const {
        const int row0 = u.pm * BM + wr * 64 + fr, col0 = u.pn * BM + wc * 32 + 8 * fq;
        const float sc = (u.pn * BM < qcols) ? qscale : 1.0f;
#pragma unroll
        for (int ai = 0; ai < 2; ++ai)
#pragma unroll
            for (int m = 0; m < 4; ++m) { bf16_t* rowp = O + (size_t)(row0 + ai * HALF + m * 16) * ldc + col0;
#pragma unroll
                for (int bj = 0; bj < 2; ++bj) { const f32x4 v0 = acc[ai][bj][m][0] * sc, v1 = acc[ai][bj][m][1] * sc;
                    u32x4 w; w.x = cvt_pk_bf16(v0[0], v0[1]); w.y = cvt_pk_bf16(v0[2], v0[3]); w.z = cvt_pk_bf16(v1[0], v1[1]); w.w = cvt_pk_bf16(v1[2], v1[3]);
                    *(u32x4*)(rowp + bj * HALF) = w; } }
    }
};
struct EpiResF32 {
    static constexpr bool PERM = false, AFTER_DRAIN = false;
    const float* base; float* out; int ldc;
    __device__ __forceinline__ void operator()(const f32x4 (&acc)[2][2][4][2], const Unit& u, int wr, int wc, int fr, int fq) const {
        const int row0 = u.pm * BM + wr * 64 + fr, col0 = u.pn * BM + wc * 32 + 4 * fq;
#pragma unroll
        for (int ai = 0; ai < 2; ++ai)
#pragma unroll
            for (int m = 0; m < 4; ++m) { const size_t off = (size_t)(row0 + ai * HALF + m * 16) * ldc + col0;
#pragma unroll
                for (int bj = 0; bj < 2; ++bj)
#pragma unroll
                    for (int n = 0; n < 2; ++n) { const f32x4 b = *(const f32x4*)(base + off + bj * HALF + n * 16); *(f32x4*)(out + off + bj * HALF + n * 16) = b + acc[ai][bj][m][n]; } }
    }
};
struct EpiGateMul {
    static constexpr bool PERM = true, AFTER_DRAIN = false;
    bf16_t* O; int ldc;
    __device__ __forceinline__ float sg(float o, float g) const { return o * g / (1.0f + __expf(-g)); }
    __device__ __forceinline__ void operator()(const f32x4 (&acc)[2][2][4][2], const Unit& u, int wr, int wc, int fr, int fq) const {
        const int row0 = u.pm * BM + wr * 64 + fr, col0 = u.pn * BM + wc * 32 + 8 * fq;
#pragma unroll
        for (int ai = 0; ai < 2; ++ai)
#pragma unroll
            for (int m = 0; m < 4; ++m) { bf16_t* rowp = O + (size_t)(row0 + ai * HALF + m * 16) * ldc + col0;
#pragma unroll
                for (int bj = 0; bj < 2; ++bj) { const f32x4 v0 = acc[ai][bj][m][0], v1 = acc[ai][bj][m][1];
                    const u32x4 ov = *(const u32x4*)(rowp + bj * HALF);
                    u32x4 w; w.x = cvt_pk_bf16(sg(bf_lo(ov.x), v0[0]), sg(bf_hi(ov.x), v0[1])); w.y = cvt_pk_bf16(sg(bf_lo(ov.y), v0[2]), sg(bf_hi(ov.y), v0[3]));
                    w.z = cvt_pk_bf16(sg(bf_lo(ov.z), v1[0]), sg(bf_hi(ov.z), v1[1])); w.w = cvt_pk_bf16(sg(bf_lo(ov.w), v1[2]), sg(bf_hi(ov.w), v1[3]));
                    *(u32x4*)(rowp + bj * HALF) = w; } }
    }
};
template <class Epi, class Sched, bool ALIGN_EPI = false, bool SP2 = false>
__device__ __forceinline__ void gemm_phase(PG8_LAS unsigned char* lds, const Gemm g, const Sched& S, const Epi& E) {
    int tid_ = threadIdx.x; asm volatile("" : "+v"(tid_));
    const int tid = tid_, wid = __builtin_amdgcn_readfirstlane(tid >> 6), lane = tid & 63, wr = wid >> 2, wc = wid & 3, fr = lane & 15, fq = lane >> 4;
    const int K = g.K, nt = K / BK;
    unsigned voffA[2], voffB[2];
#pragma unroll
    for (int i = 0; i < 2; ++i) { int R, C; stage_rc(tid * 16 + i * 8192, R, C); const int Rb = Epi::PERM ? ((R & ~31) + perm32(R & 31)) : R;
        voffA[i] = (unsigned)(R * K + C) * 2u; voffB[i] = (unsigned)(Rb * K + C) * 2u; }
    const size_t kstep = (size_t)(BK * 2);
    const size_t hstep = (size_t)HALF * K * 2;
    const size_t tstep = 2 * hstep;
    const unsigned ldsw = (unsigned)wid * 1024u;
    const int aoff = lds_byte(wr * 64 + fr, fq * 8), boff = lds_byte(wc * 32 + fr, fq * 8);
#define PG8_SA(b, h) (((b) * 2 + (h)) * HTB)
#define PG8_SB(b, h) ((4 + (b) * 2 + (h)) * HTB)
#define PG8_STAGE(bufoff, gbase, voff) do { _Pragma("unroll") for (int _i = 0; _i < 2; ++_i) \
        __builtin_amdgcn_global_load_lds((const unsigned*)((const char*)(gbase) + (voff)[_i]), (PG8_LAS unsigned*)(lds + (bufoff) + ldsw + _i * 8192), 16, 0, 0); } while (0)
#define PG8_LDA(dst, b, h) do { _Pragma("unroll") for (int m = 0; m < 4; ++m) _Pragma("unroll") for (int k = 0; k < 2; ++k) dst[m][k] = *(const PG8_LAS bf16x8*)(lds + PG8_SA(b, h) + aoff + m * 2048 + k * 1024); } while (0)
#define PG8_LDB(dst, b, h) do { _Pragma("unroll") for (int n = 0; n < 2; ++n) _Pragma("unroll") for (int k = 0; k < 2; ++k) dst[n][k] = *(const PG8_LAS bf16x8*)(lds + PG8_SB(b, h) + boff + n * 2048 + k * 1024); } while (0)
#define PG8_MMA(ai, bj, At, Bt) do { __builtin_amdgcn_s_setprio(1); _Pragma("unroll") for (int m = 0; m < 4; ++m) _Pragma("unroll") for (int n = 0; n < 2; ++n) _Pragma("unroll") for (int k = 0; k < 2; ++k) \
        acc[ai][bj][m][n] = __builtin_amdgcn_mfma_f32_16x16x32_bf16(Bt[n][k], At[m][k], acc[ai][bj][m][n], 0, 0, 0); __builtin_amdgcn_s_setprio(0); } while (0)
#define PG8_WAIT_V(n) asm volatile("s_waitcnt vmcnt(" #n ")" ::: "memory")
#define PG8_WAIT_L(n) asm volatile("s_waitcnt lgkmcnt(" #n ")" ::: "memory")
#define PG8_BAR __builtin_amdgcn_s_barrier()
#define PG8_SCHED __builtin_amdgcn_sched_barrier(0)
    Unit cur, nxt; int ui = 0;
    if (!S.next(0, cur)) return;
    f32x4 acc[2][2][4][2];
#pragma unroll
    for (int a = 0; a < 2; ++a)
#pragma unroll
        for (int b = 0; b < 2; ++b)
#pragma unroll
            for (int m = 0; m < 4; ++m)
#pragma unroll
                for (int n = 0; n < 2; ++n) acc[a][b][m][n] = (f32x4){0.f, 0.f, 0.f, 0.f};
    bf16x8 At[4][2], B0[2][2], B1[2][2];
    const char* cA = (const char*)g.A + (size_t)cur.pm * tstep; const char* cB = (const char*)g.Bt + (size_t)cur.pn * tstep;
    S.a_ready(cur);
    if constexpr (SP2) {
        PG8_STAGE(PG8_SB(0, 0), cB, voffB); PG8_STAGE(PG8_SB(0, 1), cB + hstep, voffB); PG8_STAGE(PG8_SA(0, 0), cA, voffA); PG8_STAGE(PG8_SA(0, 1), cA + hstep, voffA);
        if (wr == 1) PG8_BAR;
        PG8_WAIT_V(2); PG8_BAR;
        PG8_STAGE(PG8_SB(1, 0), cB + kstep, voffB); PG8_STAGE(PG8_SA(1, 0), cA + kstep, voffA); PG8_STAGE(PG8_SB(1, 1), cB + hstep + kstep, voffB);
        PG8_WAIT_V(6); PG8_BAR;
    } else {
        PG8_STAGE(PG8_SB(0, 0), cB, voffB); PG8_STAGE(PG8_SA(0, 0), cA, voffA); PG8_STAGE(PG8_SB(0, 1), cB + hstep, voffB); PG8_STAGE(PG8_SA(0, 1), cA + hstep, voffA);
        if (wr == 1) PG8_BAR;
        PG8_WAIT_V(4); PG8_BAR;
        PG8_STAGE(PG8_SB(1, 0), cB + kstep, voffB); PG8_STAGE(PG8_SA(1, 0), cA + kstep, voffA); PG8_STAGE(PG8_SB(1, 1), cB + hstep + kstep, voffB);
        PG8_WAIT_V(6); PG8_BAR;
    }
    for (;;) {
        const bool has_next = S.next(ui + 1, nxt);
        const char* nA = has_next ? (const char*)g.A + (size_t)nxt.pm * tstep : cA; const char* nB = has_next ? (const char*)g.Bt + (size_t)nxt.pn * tstep : cB;
        for (int t = 0; t < nt; t += 2) {
            const bool last = (t == nt - 2);
            const char* a1 = cA + (size_t)(t + 1) * kstep;
            const char* a2 = last ? nA : cA + (size_t)(t + 2) * kstep; const char* b2 = last ? nB : cB + (size_t)(t + 2) * kstep;
            const char* a3 = a2 + kstep; const char* b3 = b2 + kstep;
            if (last && has_next) S.a_ready(nxt);
            if constexpr (SP2) {
            PG8_LDB(B0, 0, 0); PG8_LDB(B1, 0, 1); PG8_SCHED; PG8_LDA(At, 0, 0); PG8_STAGE(PG8_SA(1, 1), a1 + hstep, voffA);
            PG8_WAIT_V(8); PG8_WAIT_L(0); PG8_BAR; PG8_MMA(0, 0, At, B0); PG8_MMA(0, 1, At, B1); PG8_BAR; PG8_SCHED;
            PG8_LDA(At, 0, 1); PG8_STAGE(PG8_SB(0, 0), b2, voffB); PG8_STAGE(PG8_SB(0, 1), b2 + hstep, voffB); PG8_STAGE(PG8_SA(0, 0), a2, voffA);
            PG8_WAIT_V(8); PG8_WAIT_L(0); PG8_BAR; PG8_MMA(1, 0, At, B0); PG8_MMA(1, 1, At, B1); PG8_BAR; PG8_SCHED;
            PG8_LDB(B0, 1, 0); PG8_LDB(B1, 1, 1); PG8_SCHED; PG8_LDA(At, 1, 0); PG8_STAGE(PG8_SA(0, 1), a2 + hstep, voffA);
            PG8_WAIT_V(8); PG8_WAIT_L(0); PG8_BAR; PG8_MMA(0, 0, At, B0); PG8_MMA(0, 1, At, B1); PG8_BAR; PG8_SCHED;
            PG8_LDA(At, 1, 1); PG8_STAGE(PG8_SB(1, 0), b3, voffB); PG8_STAGE(PG8_SB(1, 1), b3 + hstep, voffB); PG8_STAGE(PG8_SA(1, 0), a3, voffA);
            PG8_WAIT_V(8); PG8_WAIT_L(0); PG8_BAR; PG8_MMA(1, 0, At, B0); PG8_MMA(1, 1, At, B1); PG8_BAR; PG8_SCHED;
            } else {
            PG8_LDB(B0, 0, 0); PG8_SCHED; PG8_LDA(At, 0, 0); PG8_STAGE(PG8_SA(1, 1), a1 + hstep, voffA);
            PG8_WAIT_L(8); PG8_BAR; PG8_WAIT_L(0); PG8_MMA(0, 0, At, B0); PG8_BAR; PG8_SCHED;
            PG8_LDB(B1, 0, 1); PG8_STAGE(PG8_SB(0, 0), b2, voffB);
            PG8_BAR; PG8_WAIT_L(0); PG8_MMA(0, 1, At, B1); PG8_BAR;
            PG8_LDA(At, 0, 1); PG8_STAGE(PG8_SA(0, 0), a2, voffA);
            PG8_BAR; PG8_WAIT_L(0); PG8_MMA(1, 0, At, B0); PG8_BAR; PG8_SCHED;
            PG8_STAGE(PG8_SB(0, 1), b2 + hstep, voffB);
            PG8_WAIT_V(6); PG8_BAR; PG8_MMA(1, 1, At, B1); PG8_BAR;
            PG8_LDB(B0, 1, 0); PG8_SCHED; PG8_LDA(At, 1, 0); PG8_STAGE(PG8_SA(0, 1), a2 + hstep, voffA);
            PG8_WAIT_L(8); PG8_BAR; PG8_WAIT_L(0); PG8_MMA(0, 0, At, B0); PG8_BAR; PG8_SCHED;
            PG8_LDB(B1, 1, 1); PG8_STAGE(PG8_SB(1, 0), b3, voffB);
            PG8_BAR; PG8_WAIT_L(0); PG8_MMA(0, 1, At, B1); PG8_BAR;
            PG8_LDA(At, 1, 1); PG8_STAGE(PG8_SA(1, 0), a3, voffA);
            PG8_BAR; PG8_WAIT_L(0); PG8_MMA(1, 0, At, B0); PG8_BAR; PG8_SCHED;
            PG8_STAGE(PG8_SB(1, 1), b3 + hstep, voffB);
            PG8_WAIT_V(6); PG8_BAR; PG8_MMA(1, 1, At, B1); PG8_BAR;
            }
        }
        if constexpr (ALIGN_EPI) { if (wr == 0) PG8_BAR; }
        if constexpr (!Epi::AFTER_DRAIN) { E(acc, cur, wr, wc, fr, fq); S.done(cur); }
        if (!has_next) break;
#pragma unroll
        for (int a = 0; a < 2; ++a)
#pragma unroll
            for (int b = 0; b < 2; ++b)
#pragma unroll
                for (int m = 0; m < 4; ++m)
#pragma unroll
                    for (int n = 0; n < 2; ++n) acc[a][b][m][n] = (f32x4){0.f, 0.f, 0.f, 0.f};
        cur = nxt; cA = nA; cB = nB; ++ui;
        if constexpr (ALIGN_EPI) { if (wr == 1) PG8_BAR; }
    }
    PG8_WAIT_V(0);
    if constexpr (!ALIGN_EPI) { if (wr == 0) PG8_BAR; }
    PG8_BAR;
    if constexpr (Epi::AFTER_DRAIN) { E.fused(acc, cur, wr, wc, fr, fq, lds, wid, lane); S.done(cur); }
#undef PG8_SA
#undef PG8_SB
#undef PG8_STAGE
#undef PG8_LDA
#undef PG8_LDB
#undef PG8_MMA
#undef PG8_WAIT_V
#undef PG8_WAIT_L
#undef PG8_BAR
#undef PG8_SCHED
}
}
#ifndef PG8_SP2
#define PG8_SP2 true
#endif
#ifndef PG8_ALIGN
#define PG8_ALIGN true
#endif
constexpr int NWAVES = 8;
constexpr int BATCH = 2, SEQ = 16384, DM = 1024, DI = 2048, T = BATCH * SEQ;
constexpr int HG_COLS = 4 * DI;
constexpr int ATT_COLS = 10 * DI;
constexpr int QKV_COLS = 3 * DI;
constexpr float EPS = 1e-6f;
constexpr size_t MiB = 1u << 20;
constexpr size_t WS_CTL = 0;
constexpr size_t WS_WHGIN = 1 * MiB, WS_WHGOUT = 17 * MiB, WS_WATTIN = 21 * MiB, WS_WATTOUT = 61 * MiB;
constexpr size_t WS_LSE = 65 * MiB;
constexpr size_t WS_BIG0 = 96 * MiB;
constexpr size_t WS_U1 = WS_BIG0, WS_QKV = WS_BIG0 + 64 * MiB;
constexpr size_t WS_BIG1 = 352 * MiB;
constexpr size_t WS_END = 480 * MiB;
constexpr int RING_BYTES = 131072;
constexpr int LDS_BYTES = 147456;
enum { PH_PRO = 0, PH_G1_0 = 1, PH_HGA_0 = 2, PH_HGB_0 = 3, PH_G1_1 = 4, PH_HGA_1 = 5, PH_HGB_1 = 6, PH_G2 = 7, PH_NORM1 = 8, PH_G3_0 = 9  , PH_GATE = 21, PH_G5 = 22, PH_FINAL = 23, PH_END = 24 };

#define LAS __attribute__((address_space(3)))
typedef unsigned short bf16;
typedef unsigned v4u __attribute__((ext_vector_type(4)));
typedef float f32x4 __attribute__((ext_vector_type(4)));
#define LDS_WAIT() asm volatile("s_waitcnt lgkmcnt(0)" ::: "memory")
__device__ __forceinline__ unsigned f2bf(float f) { unsigned u = __builtin_bit_cast(unsigned, f); return (u + 0x7fffu + ((u >> 16) & 1u)) >> 16; }
__device__ __forceinline__ unsigned pk2(float lo, float hi) { return f2bf(lo) | (f2bf(hi) << 16); }
__device__ __forceinline__ float bf2f(unsigned short b) { return __uint_as_float(((unsigned)b) << 16); }
__device__ __forceinline__ float blo(unsigned w) { return __uint_as_float(w << 16); }
__device__ __forceinline__ float bhi(unsigned w) { return __uint_as_float(w & 0xffff0000u); }
__device__ __forceinline__ float wave_sum(float v) {
#pragma unroll
    for (int o = 1; o < 64; o <<= 1) v += __shfl_xor(v, o);
    return v;
}
__device__ const unsigned char BUCKET[3][129] = {
{0,1,2,3,4,5,6,7,8,9,10,11,12,13,14,15,16,16,16,16,16,16,17,17,17,17,17,17,17,17,18,18,18,18,18,18,18,18,18,18,19,19,19,19,19,19,19,19,19,19,19,19,19,19,20,20,20,20,20,20,20,20,20,20,20,20,20,20,20,20,20,20,20,21,21,21,21,21,21,21,21,21,21,21,21,21,21,21,21,21,21,21,21,21,21,21,21,21,21,22,22,22,22,22,22,22,22,22,22,22,22,22,22,22,22,22,22,22,22,22,22,22,22,22,22,22,22,22,22},
{0,4,8,12,16,16,17,17,18,18,19,19,19,19,20,20,20,20,20,21,21,21,21,21,21,22,22,22,22,22,22,22,22,22,23,23,23,23,23,23,23,23,23,23,23,23,24,24,24,24,24,24,24,24,24,24,24,24,24,24,24,24,25,25,25,25,25,25,25,25,25,25,25,25,25,25,25,25,25,25,25,25,25,26,26,26,26,26,26,26,26,26,26,26,26,26,26,26,26,26,26,26,26,26,26,26,26,26,26,26,26,26,26,27,27,27,27,27,27,27,27,27,27,27,27,27,27,27,27},
{0,16,18,19,20,21,21,22,22,23,23,23,24,24,24,24,25,25,25,25,25,26,26,26,26,26,26,26,26,27,27,27,27,27,27,27,27,27,27,28,28,28,28,28,28,28,28,28,28,28,28,28,29,29,29,29,29,29,29,29,29,29,29,29,29,29,29,29,29,29,30,30,30,30,30,30,30,30,30,30,30,30,30,30,30,30,30,30,30,30,30,30,30,30,30,31,31,31,31,31,31,31,31,31,31,31,31,31,31,31,31,31,31,31,31,31,31,31,31,31,31,31,31,31,31,31,31,31,31}};

__device__ __forceinline__ void p0_transpose_item(const float* W, int K, int N, bf16* WT, LAS float* scr, int item, int lane) {
    const int nblk = N / 32, kb = item / nblk, nb = item % nblk, k0 = 64 * kb, n0 = 32 * nb;
#pragma unroll 8
    for (int i = 0; i < 32; ++i) { const int kk = 2 * i + (lane >> 5); scr[kk * 33 + (lane & 31)] = W[(size_t)(k0 + kk) * N + n0 + (lane & 31)]; }
    LDS_WAIT(); asm volatile("" ::: "memory");
    const int c = lane & 7;
#pragma unroll
    for (int j = 0; j < 4; ++j) { const int n = (lane >> 3) + 8 * j; const LAS float* s = scr + (8 * c) * 33 + n;
        v4u o; o.x = pk2(s[0 * 33], s[1 * 33]); o.y = pk2(s[2 * 33], s[3 * 33]); o.z = pk2(s[4 * 33], s[5 * 33]); o.w = pk2(s[6 * 33], s[7 * 33]);
        *(v4u*)(WT + (size_t)(n0 + n) * K + k0 + 8 * c) = o; }
    LDS_WAIT(); asm volatile("" ::: "memory");
}
__device__ __forceinline__ void rms_row_to_bf16(const float* xrow, const float* g, bf16* orow, int lane) {
    const f32x4* xr = (const f32x4*)xrow + lane; const f32x4* gr = (const f32x4*)g + lane;
    f32x4 v[4]; float s = 0.f;
#pragma unroll
    for (int j = 0; j < 4; ++j) { v[j] = xr[64 * j]; s += (v[j].x * v[j].x + v[j].y * v[j].y) + (v[j].z * v[j].z + v[j].w * v[j].w); }
    const float rs = 1.0f / sqrtf(wave_sum(s) * (1.0f / DM) + EPS);
    unsigned long long* o8 = (unsigned long long*)orow + lane;
#pragma unroll
    for (int j = 0; j < 4; ++j) { const f32x4 gv = gr[64 * j]; const f32x4 o = v[j] * rs * gv;
        o8[64 * j] = (unsigned long long)pk2(o.x, o.y) | ((unsigned long long)pk2(o.z, o.w) << 32); }
}
__device__ __forceinline__ void rms_row_inplace_f32(float* xrow, const float* g, int lane) {
    f32x4* xr = (f32x4*)xrow + lane; const f32x4* gr = (const f32x4*)g + lane;
    f32x4 v[4]; float s = 0.f;
#pragma unroll
    for (int j = 0; j < 4; ++j) { v[j] = xr[64 * j]; s += (v[j].x * v[j].x + v[j].y * v[j].y) + (v[j].z * v[j].z + v[j].w * v[j].w); }
    const float rs = 1.0f / sqrtf(wave_sum(s) * (1.0f / DM) + EPS);
#pragma unroll
    for (int j = 0; j < 4; ++j) { const f32x4 gv = gr[64 * j]; xr[64 * j] = v[j] * rs * gv; }
}

__device__ __forceinline__ void naive_hgrn(LAS unsigned char* lds, int h, int e, bool active, const bf16* __restrict__ qfig, const float* __restrict__ lb_logits, const float* __restrict__ norm_g, bf16* __restrict__ y) {
    const int col = h * 128 + e;
    LAS float* sq = (LAS float*)lds; LAS float* sf = sq + 16 * 128; LAS float* sv = sf + 16 * 128; LAS float* so = sv + 16 * 128;
    float S[128];
#pragma unroll
    for (int d = 0; d < 128; ++d) S[d] = 0.f;
    float lb = 0.f;
    if (active) { const float l0 = lb_logits[col], l1 = lb_logits[DI + col], l2 = lb_logits[2 * DI + col];
        const float mx = fmaxf(l0, fmaxf(l1, l2)); const float e0 = expf(l0 - mx), e1 = expf(l1 - mx), e2 = expf(l2 - mx);
        lb = e0 / (e0 + e1 + e2); }
    for (int t0 = 0; t0 < SEQ; t0 += 16) {
        if (active) for (int c = 0; c < 16; ++c) { const bf16* row = qfig + (size_t)(t0 + c) * HG_COLS + col;
            sq[c * 128 + e] = bf2f(row[0]); const float fp = bf2f(row[DI]); sf[c * 128 + e] = lb + (1.f - lb) / (1.f + expf(-fp)); sv[c * 128 + e] = bf2f(row[2 * DI]); }
        __syncthreads();
        if (active) for (int c = 0; c < 16; ++c) { const float v = sv[c * 128 + e]; float o = 0.f;
#pragma unroll
            for (int d = 0; d < 128; ++d) { const float f = sf[c * 128 + d]; S[d] = f * S[d] + (1.f - f) * v; o += sq[c * 128 + d] * S[d]; }
            so[c * 128 + e] = o; }
        __syncthreads();
        if (active) { const int w = e >> 6, lane = e & 63;
        for (int cc = 0; cc < 8; ++cc) { const int c = w * 8 + cc; const float a = so[c * 128 + lane], b2 = so[c * 128 + lane + 64];
            const float ss = wave_sum(a * a + b2 * b2);
            const float rs = 1.0f / sqrtf(ss * (1.0f / 128.0f) + EPS);
            const bf16* grow = qfig + (size_t)(t0 + c) * HG_COLS + 3 * DI + h * 128;
            bf16* yrow = y + (size_t)(t0 + c) * DI + h * 128;
            for (int k = 0; k < 2; ++k) { const int ee = lane + 64 * k; const float g = bf2f(grow[ee]); const float ov = (k ? b2 : a) * rs * norm_g[h * 128 + ee];
                yrow[ee] = (bf16)f2bf(ov * g / (1.f + expf(-g))); } } }
        __syncthreads();
    }
}
__device__ __forceinline__ void naive_attn(int idx, const bf16* __restrict__ qkv, const float* __restrict__ rel_bias, bf16* __restrict__ oacc, float* __restrict__ lseacc, int g) {
    const int h = idx & 15, t = idx >> 4;
    const int dil = g == 0 ? 1 : (g == 1 ? 4 : 16);
    const v4u* qp = (const v4u*)(qkv + (size_t)t * QKV_COLS + h * 128);
    float la = 0.f; if (g > 0) la = lseacc[t * 16 + h];
    float ln = 0.f;
    for (int half = 0; half < 2; ++half) {
        float o[64];
#pragma unroll
        for (int i = 0; i < 64; ++i) o[i] = 0.f;
        float m = -1e30f, l = 0.f;
        for (int j = 0; j <= 128; ++j) { const int tk = t - j * dil; if (tk < 0) break;
            const v4u* kp = (const v4u*)(qkv + (size_t)tk * QKV_COLS + DI + h * 128);
            const v4u* vp = (const v4u*)(qkv + (size_t)tk * QKV_COLS + 2 * DI + h * 128 + half * 64);
            float s = 0.f;
#pragma unroll
            for (int i = 0; i < 16; ++i) { const v4u a = qp[i], b = kp[i];
                s += blo(a.x) * blo(b.x) + bhi(a.x) * bhi(b.x) + blo(a.y) * blo(b.y) + bhi(a.y) * bhi(b.y) + blo(a.z) * blo(b.z) + bhi(a.z) * bhi(b.z) + blo(a.w) * blo(b.w) + bhi(a.w) * bhi(b.w); }
            s = s * 0.08838834764831845f + rel_bias[(int)BUCKET[g][j] * 48 + g * 16 + h];
            const float mn = fmaxf(m, s); const float alpha = expf(m - mn), p = expf(s - mn);
            l = l * alpha + p; m = mn;
#pragma unroll
            for (int i = 0; i < 8; ++i) { const v4u b = vp[i];
                o[8 * i + 0] = o[8 * i + 0] * alpha + p * blo(b.x); o[8 * i + 1] = o[8 * i + 1] * alpha + p * bhi(b.x);
                o[8 * i + 2] = o[8 * i + 2] * alpha + p * blo(b.y); o[8 * i + 3] = o[8 * i + 3] * alpha + p * bhi(b.y);
                o[8 * i + 4] = o[8 * i + 4] * alpha + p * blo(b.z); o[8 * i + 5] = o[8 * i + 5] * alpha + p * bhi(b.z);
                o[8 * i + 6] = o[8 * i + 6] * alpha + p * blo(b.w); o[8 * i + 7] = o[8 * i + 7] * alpha + p * bhi(b.w); }
        }
        const float lse = m + logf(l);
        float wa = 0.f, wg = 1.0f / l; ln = lse;
        v4u* op = (v4u*)(oacc + (size_t)t * DI + h * 128 + half * 64);
        if (g > 0) { const float mm = fmaxf(la, lse); ln = mm + logf(expf(la - mm) + expf(lse - mm)); wa = expf(la - ln); wg = expf(lse - ln) / l; }
#pragma unroll
        for (int i = 0; i < 8; ++i) { v4u a = (v4u){0u, 0u, 0u, 0u}; if (g > 0) a = op[i];
            v4u r; r.x = pk2(wa * blo(a.x) + wg * o[8 * i + 0], wa * bhi(a.x) + wg * o[8 * i + 1]); r.y = pk2(wa * blo(a.y) + wg * o[8 * i + 2], wa * bhi(a.y) + wg * o[8 * i + 3]);
            r.z = pk2(wa * blo(a.z) + wg * o[8 * i + 4], wa * bhi(a.z) + wg * o[8 * i + 5]); r.w = pk2(wa * blo(a.w) + wg * o[8 * i + 6], wa * bhi(a.w) + wg * o[8 * i + 7]);
            op[i] = r; }
    }
    lseacc[t * 16 + h] = ln;
}

typedef short bf16x8 __attribute__((ext_vector_type(8)));
typedef short s16x4 __attribute__((ext_vector_type(4)));
typedef float f32x16 __attribute__((ext_vector_type(16)));
typedef unsigned u32x2v __attribute__((ext_vector_type(2)));
__device__ __forceinline__ unsigned cvtpk(float lo, float hi) { unsigned r; asm volatile("v_cvt_pk_bf16_f32 %0, %1, %2" : "=v"(r) : "v"(lo), "v"(hi)); return r; }
__device__ __forceinline__ bf16x8 pack8(float a0, float a1, float a2, float a3, float a4, float a5, float a6, float a7) {
    v4u w; w.x = cvtpk(a0, a1); w.y = cvtpk(a2, a3); w.z = cvtpk(a4, a5); w.w = cvtpk(a6, a7); return __builtin_bit_cast(bf16x8, w);
}
__device__ __forceinline__ int crow(int r) { return (r & 3) + 8 * (r >> 2); }

constexpr int HG_QF = 0, HG_KIF = 8192, HG_KDF = 16384, HG_VF = 24576, HG_OB = 32768, HG_OBLD = 132, HG_TT = HG_OB + 32 * HG_OBLD * 4, HG_AD = HG_TT + 2048, HG_LDS_END = HG_AD + 512;
constexpr size_t WS_HGU = 67 * MiB, WS_HGA = 83 * MiB;
template <bool OUT>
__device__ __forceinline__ void hgrn_pass(LAS unsigned char* lds, int item, int tid, const bf16* __restrict__ qfig, const float* __restrict__ lb_logits, const float* __restrict__ norm_g, float* __restrict__ Ust, float* __restrict__ Ast, bf16* __restrict__ y) {
    const int h = item >> 4, J = item & 15;
    const int lane = tid & 63, w = __builtin_amdgcn_readfirstlane(tid >> 6), l15 = lane & 15, q4 = lane >> 4;
    const int col = tid & 127, cq = tid >> 7;
    const int eg = 16 * w + l15;
    float lb;
    { const int gc = h * 128 + col; const float l0 = lb_logits[gc], l1 = lb_logits[DI + gc], l2 = lb_logits[2 * DI + gc];
      const float mx = fmaxf(l0, fmaxf(l1, l2)); const float e0 = __expf(l0 - mx), e1 = __expf(l1 - mx), e2 = __expf(l2 - mx); lb = e0 / (e0 + e1 + e2); }
    f32x4 S[8];
#pragma unroll
    for (int dt = 0; dt < 8; ++dt) S[dt] = (f32x4){0.f, 0.f, 0.f, 0.f};
    if (OUT) {
        for (int Jp = 0; Jp < J; ++Jp) { const float* Ub = Ust + (size_t)(h * 16 + Jp) * 16384; const float* Ab = Ast + (h * 16 + Jp) * 128;
#pragma unroll
            for (int dt = 0; dt < 8; ++dt)
#pragma unroll
                for (int r = 0; r < 4; ++r) { const int d = 16 * dt + 4 * q4 + r; S[dt][r] = Ab[d] * S[dt][r] + Ub[d * 128 + eg]; } }
    }
    float atot = 1.0f;
    const int pc = tid >> 4, pe = tid & 15;
    f32x4 ng0 = (f32x4){0.f, 0.f, 0.f, 0.f}, ng1 = ng0;
    if (OUT) { ng0 = *(const f32x4*)(norm_g + h * 128 + 8 * pe); ng1 = *(const f32x4*)(norm_g + h * 128 + 8 * pe + 4); }
    const bf16* base = qfig + (size_t)(J * 1024) * HG_COLS + h * 128;
    for (int n = 0; n < 32; ++n) {
        const bf16* cb = base + (size_t)(n * 32 + 8 * cq) * HG_COLS + col;
        float qv[8], kv[8], cs[8]; unsigned short vraw[8];
#pragma unroll
        for (int cc = 0; cc < 8; ++cc) { const bf16* p = cb + (size_t)cc * HG_COLS;
            const float fp = bf2f(p[DI]); vraw[cc] = p[2 * DI]; if (OUT) qv[cc] = bf2f(p[0]); else qv[cc] = 0.f;
            const float f = lb + (1.0f - lb) / (1.0f + __expf(-fp));
            kv[cc] = 1.0f - f; const float lf = __logf(f); cs[cc] = cc ? cs[cc - 1] + lf : lf; }
        ((LAS float*)(lds + HG_TT))[cq * 128 + col] = cs[7];
        __syncthreads();
        { const LAS float* TT = (const LAS float*)(lds + HG_TT); const float T0 = TT[col], T1 = TT[128 + col], T2 = TT[256 + col], T3 = TT[384 + col];
          const float off = (cq > 0 ? T0 : 0.f) + (cq > 1 ? T1 : 0.f) + (cq > 2 ? T2 : 0.f); const float total = (T0 + T1) + (T2 + T3);
          const float adec = __expf(total); atot *= adec;
          if (cq == 0) ((LAS float*)(lds + HG_AD))[col] = adec;
          float kd[8];
          const int ks = col >> 5, tq = (col >> 2) & 3, jjd = 4 * ((col >> 4) & 1) + (col & 3);
#pragma unroll
          for (int cc = 0; cc < 8; ++cc) { const int c = 8 * cq + cc; const float b = off + cs[cc];
              kd[cc] = kv[cc] * __expf(total - b);
              if (OUT) { const float eb = __expf(b), enb = __expf(-b);
                  const int byte = c * 256 + (((ks * 4 + tq) ^ (c & 15)) * 16) + jjd * 2;
                  *(LAS unsigned short*)(lds + HG_QF + byte) = (unsigned short)f2bf(qv[cc] * eb);
                  *(LAS unsigned short*)(lds + HG_KIF + byte) = (unsigned short)f2bf(kv[cc] * enb); } }
          const int i4 = 4 * (cq >> 1), qa = 2 * (cq & 1), sw = (col >> 2) & 3;
          u32x2v w0, w1;
          w0.x = cvtpk(kd[0], kd[1]); w0.y = cvtpk(kd[2], kd[3]); w1.x = cvtpk(kd[4], kd[5]); w1.y = cvtpk(kd[6], kd[7]);
          *(LAS u32x2v*)(lds + HG_KDF + col * 64 + ((qa ^ sw) * 16) + i4 * 2) = w0;
          *(LAS u32x2v*)(lds + HG_KDF + col * 64 + (((qa + 1) ^ sw) * 16) + i4 * 2) = w1;
          w0.x = (unsigned)vraw[0] | ((unsigned)vraw[1] << 16); w0.y = (unsigned)vraw[2] | ((unsigned)vraw[3] << 16); w1.x = (unsigned)vraw[4] | ((unsigned)vraw[5] << 16); w1.y = (unsigned)vraw[6] | ((unsigned)vraw[7] << 16);
          *(LAS u32x2v*)(lds + HG_VF + col * 64 + ((qa ^ sw) * 16) + i4 * 2) = w0;
          *(LAS u32x2v*)(lds + HG_VF + col * 64 + (((qa + 1) ^ sw) * 16) + i4 * 2) = w1; }
        __syncthreads();
        const bf16x8 vfrag = *(const LAS bf16x8*)(lds + HG_VF + eg * 64 + ((q4 ^ ((eg >> 2) & 3)) * 16));
        if (OUT) {
            bf16x8 qf[2][4], kif[2][4];
#pragma unroll
            for (int jt = 0; jt < 2; ++jt)
#pragma unroll
                for (int ks = 0; ks < 4; ++ks) { const int c = 16 * jt + l15; const int byte = c * 256 + (((ks * 4 + q4) ^ (c & 15)) * 16);
                    qf[jt][ks] = *(const LAS bf16x8*)(lds + HG_QF + byte); kif[jt][ks] = *(const LAS bf16x8*)(lds + HG_KIF + byte); }
            f32x4 sc[2][2];
#pragma unroll
            for (int i = 0; i < 2; ++i)
#pragma unroll
                for (int jt = 0; jt < 2; ++jt) { sc[i][jt] = (f32x4){0.f, 0.f, 0.f, 0.f};
#pragma unroll
                    for (int ks = 0; ks < 4; ++ks) sc[i][jt] = __builtin_amdgcn_mfma_f32_16x16x32_bf16(kif[i][ks], qf[jt][ks], sc[i][jt], 0, 0, 0); }
            f32x4 o[2];
#pragma unroll
            for (int jt = 0; jt < 2; ++jt) { const int c = 16 * jt + l15; float pm[8];
#pragma unroll
                for (int r = 0; r < 4; ++r) { pm[r] = (4 * q4 + r <= c) ? sc[0][jt][r] : 0.f; pm[4 + r] = (16 + 4 * q4 + r <= c) ? sc[1][jt][r] : 0.f; }
                const bf16x8 pf = pack8(pm[0], pm[1], pm[2], pm[3], pm[4], pm[5], pm[6], pm[7]);
                o[jt] = __builtin_amdgcn_mfma_f32_16x16x32_bf16(pf, vfrag, (f32x4){0.f, 0.f, 0.f, 0.f}, 0, 0, 0); }
#pragma unroll
            for (int ks = 0; ks < 4; ++ks) { const bf16x8 sb = pack8(S[2 * ks][0], S[2 * ks][1], S[2 * ks][2], S[2 * ks][3], S[2 * ks + 1][0], S[2 * ks + 1][1], S[2 * ks + 1][2], S[2 * ks + 1][3]);
#pragma unroll
                for (int jt = 0; jt < 2; ++jt) o[jt] = __builtin_amdgcn_mfma_f32_16x16x32_bf16(qf[jt][ks], sb, o[jt], 0, 0, 0); }
#pragma unroll
            for (int jt = 0; jt < 2; ++jt)
#pragma unroll
                for (int r = 0; r < 4; ++r) ((LAS float*)(lds + HG_OB))[(16 * jt + 4 * q4 + r) * HG_OBLD + eg] = o[jt][r];
        }
#pragma unroll
        for (int dt = 0; dt < 8; ++dt) { const int d = 16 * dt + l15;
            const bf16x8 kdf = *(const LAS bf16x8*)(lds + HG_KDF + d * 64 + ((q4 ^ ((d >> 2) & 3)) * 16));
            const f32x4 av = *(const LAS f32x4*)(lds + HG_AD + (16 * dt + 4 * q4) * 4);
            S[dt] = __builtin_amdgcn_mfma_f32_16x16x32_bf16(kdf, vfrag, S[dt] * av, 0, 0, 0); }
        __syncthreads();
        if (OUT) {
            const LAS float* ob = (const LAS float*)(lds + HG_OB) + pc * HG_OBLD + 8 * pe;
            const f32x4 o0 = *(const LAS f32x4*)ob, o1 = *(const LAS f32x4*)(ob + 4);
            float ss = (o0.x * o0.x + o0.y * o0.y) + (o0.z * o0.z + o0.w * o0.w) + (o1.x * o1.x + o1.y * o1.y) + (o1.z * o1.z + o1.w * o1.w);
            ss += __shfl_xor(ss, 1); ss += __shfl_xor(ss, 2); ss += __shfl_xor(ss, 4); ss += __shfl_xor(ss, 8);
            const float rs = 1.0f / sqrtf(ss * (1.0f / 128.0f) + EPS);
            const size_t trow = (size_t)(J * 1024 + n * 32 + pc);
            const v4u gw4 = *(const v4u*)(qfig + trow * HG_COLS + 3 * DI + h * 128 + 8 * pe);
            const float g0 = blo(gw4.x), g1 = bhi(gw4.x), g2 = blo(gw4.y), g3 = bhi(gw4.y), g4 = blo(gw4.z), g5 = bhi(gw4.z), g6 = blo(gw4.w), g7 = bhi(gw4.w);
#define HG_Y(ov, gn, g) ((ov) * rs * (gn) * (g) / (1.0f + __expf(-(g))))
            v4u yo; yo.x = cvtpk(HG_Y(o0.x, ng0.x, g0), HG_Y(o0.y, ng0.y, g1)); yo.y = cvtpk(HG_Y(o0.z, ng0.z, g2), HG_Y(o0.w, ng0.w, g3));
            yo.z = cvtpk(HG_Y(o1.x, ng1.x, g4), HG_Y(o1.y, ng1.y, g5)); yo.w = cvtpk(HG_Y(o1.z, ng1.z, g6), HG_Y(o1.w, ng1.w, g7));
#undef HG_Y
            *(v4u*)(y + trow * DI + h * 128 + 8 * pe) = yo;
        }
    }
    if (!OUT) {
        float* Ub = Ust + (size_t)(h * 16 + J) * 16384;
#pragma unroll
        for (int dt = 0; dt < 8; ++dt)
#pragma unroll
            for (int r = 0; r < 4; ++r) Ub[(16 * dt + 4 * q4 + r) * 128 + eg] = S[dt][r];
        if (cq == 0) Ast[(h * 16 + J) * 128 + col] = atot;
    }
    __syncthreads();
}
constexpr int AT_RT = 0, AT_VT = 1024, AT_VROW = 320, AT_VTB = 32 * AT_VROW;
constexpr float LOG2E = 1.4426950408889634f, LN2 = 0.6931471805599453f;
constexpr float QSCALE = 0.08838834764831845f * LOG2E;
typedef short v4i16_t __attribute__((ext_vector_type(4)));
__device__ __forceinline__ s16x4 vtr(const LAS unsigned char* p) { return __builtin_bit_cast(s16x4, __builtin_amdgcn_ds_read_tr16_b64_v4i16((LAS v4i16_t*)p)); }
__device__ __forceinline__ void attn_phase(LAS unsigned char* lds, int vb, int G, int tid, const bf16* __restrict__ qkv, const float* __restrict__ rel_bias, bf16* __restrict__ oacc, float* __restrict__ lseacc, int g) {
    const int lane = tid & 63, w = __builtin_amdgcn_readfirstlane(tid >> 6), ql = lane & 31, hf = lane >> 5;
    const int ldil = 2 * g, dil = 1 << ldil, nqb = 512 >> ldil;
    LAS float* RT = (LAS float*)(lds + AT_RT);
    LAS unsigned char* VT = lds + AT_VT + w * AT_VTB;
    const int i15 = lane & 15, gp = (lane >> 4) & 1;
    const LAS unsigned char* vtr_base = VT + (4 * hf + (i15 >> 2)) * AT_VROW + (16 * gp + 4 * (i15 & 3)) * 2;
    for (int it0 = vb * 32; it0 < 8192; it0 += G * 32) {
        const int h = it0 >> 9;
        __syncthreads();
        if (tid < 191) { const int rel = 159 - tid; RT[tid] = (rel >= 0 && rel <= 128) ? rel_bias[(int)BUCKET[g][rel] * 48 + g * 16 + h] * LOG2E : -1e30f; }
        __syncthreads();
        for (int ii = 0; ii < 4; ++ii) {
            const int it = it0 + 4 * w + ii; const int rres = (it & 511) >> (9 - ldil), mb = it & (nqb - 1);
            const size_t tq = (size_t)((32 * mb + ql) * dil + rres);
            bf16x8 qf[8];
            { const bf16* qrow = qkv + tq * QKV_COLS + h * 128 + 8 * hf;
#pragma unroll
              for (int ks = 0; ks < 8; ++ks) qf[ks] = *(const bf16x8*)(qrow + 16 * ks); }
            f32x16 o[4];
#pragma unroll
            for (int db = 0; db < 4; ++db)
#pragma unroll
                for (int r = 0; r < 16; ++r) o[db][r] = 0.f;
            float m = -1e30f, l = 0.f;
            for (int kt = (mb > 4 ? mb - 4 : 0); kt <= mb; ++kt) {
                const int delta = mb - kt;
                bf16x8 kf[8];
                { const bf16* krow = qkv + (size_t)((32 * kt + ql) * dil + rres) * QKV_COLS + DI + h * 128 + 8 * hf;
#pragma unroll
                  for (int ks = 0; ks < 8; ++ks) kf[ks] = *(const bf16x8*)(krow + 16 * ks); }
                v4u vst[8];
#pragma unroll
                for (int jj = 0; jj < 8; ++jj) { const int cid = lane + 64 * jj, row = cid >> 4, ch = cid & 15;
                    vst[jj] = *(const v4u*)(qkv + (size_t)((32 * kt + row) * dil + rres) * QKV_COLS + 2 * DI + h * 128 + 8 * ch); }
                f32x16 s;
                { const LAS float* rt = RT + (159 - (32 * delta + ql - 4 * hf));
#pragma unroll
                  for (int r = 0; r < 16; ++r) s[r] = rt[crow(r)]; }
#pragma unroll
                for (int ks = 0; ks < 8; ++ks) s = __builtin_amdgcn_mfma_f32_32x32x16_bf16(kf[ks], qf[ks], s, 0, 0, 0);
                float mx = s[0];
#pragma unroll
                for (int r = 1; r < 16; ++r) mx = fmaxf(mx, s[r]);
                mx = fmaxf(mx, __shfl_xor(mx, 32));
                const float mn = fmaxf(m, mx); const float alpha = __builtin_amdgcn_exp2f(m - mn); m = mn;
                float rs = 0.f;
#pragma unroll
                for (int r = 0; r < 16; ++r) { s[r] = __builtin_amdgcn_exp2f(s[r] - mn); rs += s[r]; }
                l = l * alpha + rs;
#pragma unroll
                for (int db = 0; db < 4; ++db)
#pragma unroll
                    for (int r = 0; r < 16; ++r) o[db][r] *= alpha;
                const bf16x8 pb0 = pack8(s[0], s[1], s[2], s[3], s[4], s[5], s[6], s[7]), pb1 = pack8(s[8], s[9], s[10], s[11], s[12], s[13], s[14], s[15]);
#pragma unroll
                for (int jj = 0; jj < 8; ++jj) { const int cid = lane + 64 * jj, row = cid >> 4, ch = cid & 15; *(LAS v4u*)(VT + row * AT_VROW + ch * 16) = vst[jj]; }
#pragma unroll
                for (int db = 0; db < 4; ++db) {
                    const s16x4 a0 = vtr(vtr_base + db * 64), a1 = vtr(vtr_base + 8 * AT_VROW + db * 64);
                    const s16x4 b0 = vtr(vtr_base + 16 * AT_VROW + db * 64), b1 = vtr(vtr_base + 24 * AT_VROW + db * 64);
                    const bf16x8 va0 = (bf16x8){a0[0], a0[1], a0[2], a0[3], a1[0], a1[1], a1[2], a1[3]}, va1 = (bf16x8){b0[0], b0[1], b0[2], b0[3], b1[0], b1[1], b1[2], b1[3]};
                    o[db] = __builtin_amdgcn_mfma_f32_32x32x16_bf16(va0, pb0, o[db], 0, 0, 0);
                    o[db] = __builtin_amdgcn_mfma_f32_32x32x16_bf16(va1, pb1, o[db], 0, 0, 0);
                }
            }
            l += __shfl_xor(l, 32);
            const float lse = (m + __builtin_amdgcn_logf(l)) * LN2;
            float wa = 0.f, wg = 1.0f / l, ln = lse;
            float* lsp = lseacc + tq * 16 + h;
            if (g > 0) { const float la = *lsp; const float mm = fmaxf(la, lse); ln = mm + __logf(__expf(la - mm) + __expf(lse - mm)); wa = __expf(la - ln); wg = __expf(lse - ln) / l; }
            bf16* orow = oacc + tq * DI + h * 128 + 4 * hf;
#pragma unroll
            for (int db = 0; db < 4; ++db)
#pragma unroll
                for (int rq = 0; rq < 4; ++rq) { u32x2v* p = (u32x2v*)(orow + 32 * db + 8 * rq); u32x2v a = (u32x2v){0u, 0u}; if (g > 0) a = *p;
                    u32x2v rr; rr.x = cvtpk(wa * blo(a.x) + wg * o[db][4 * rq + 0], wa * bhi(a.x) + wg * o[db][4 * rq + 1]); rr.y = cvtpk(wa * blo(a.y) + wg * o[db][4 * rq + 2], wa * bhi(a.y) + wg * o[db][4 * rq + 3]);
                    *p = rr; }
            if (hf == 0) *lsp = ln;
        }
    }
    __syncthreads();
}
#ifndef FAST_HG
#define FAST_HG 1
#endif
#ifndef FAST_ATT
#define FAST_ATT 1
#endif
__device__ __forceinline__ const void* ldp(LAS unsigned char* lds, int i) {
    const unsigned long long v = ((LAS unsigned long long*)(lds + RING_BYTES))[i];
    const unsigned lo = __builtin_amdgcn_readfirstlane((unsigned)v), hi = __builtin_amdgcn_readfirstlane((unsigned)(v >> 32));
    return (const void*)(((unsigned long long)hi << 32) | lo);
}
struct Args { const float* in[10]; float* out; unsigned char* ws; int lo, hi; };
__global__ void __launch_bounds__(NWAVES * 64, 2) fwd(Args args) {
    extern __shared__ __attribute__((aligned(16))) unsigned char lds_raw[];
    LAS unsigned char* lds = (LAS unsigned char*)lds_raw;
    cg::grid_group grid = cg::this_grid();
    const int tid0 = threadIdx.x;
    const int G = gridDim.x; const int bx = blockIdx.x;
    const int vcu = (G % 8 == 0) ? (bx % 8) * (G / 8) + bx / 8 : bx;
    const int NGW = G * NWAVES;
    { LAS unsigned long long* P = (LAS unsigned long long*)(lds + RING_BYTES);
      if (tid0 < 10) P[tid0] = (unsigned long long)args.in[tid0];
      if (tid0 == 10) P[10] = (unsigned long long)args.out;
      if (tid0 == 11) P[11] = (unsigned long long)args.ws;
      __syncthreads(); }
    const int ph_hi = args.hi;
    for (int ph = args.lo; ph < ph_hi; ++ph) {
        int tid = threadIdx.x; asm volatile("" : "+v"(tid) :: "memory");
        const int lane = tid & 63, wave = __builtin_amdgcn_readfirstlane(tid >> 6), gw = vcu * NWAVES + wave;
        const float* x = (const float*)ldp(lds, 0); const float* ln_g = (const float*)ldp(lds, 1);
        unsigned char* ws = (unsigned char*)ldp(lds, 11); float* Hres = (float*)ldp(lds, 10); bf16* U0 = (bf16*)Hres;
        bf16* Whgin = (bf16*)(ws + WS_WHGIN); bf16* Whgout = (bf16*)(ws + WS_WHGOUT); bf16* Wattin = (bf16*)(ws + WS_WATTIN); bf16* Wattout = (bf16*)(ws + WS_WATTOUT);
        bf16* QFIG = (bf16*)(ws + WS_BIG0); bf16* U1 = (bf16*)(ws + WS_U1); bf16* QKV = (bf16*)(ws + WS_QKV); bf16* YB = (bf16*)(ws + WS_BIG1);
        if (ph == PH_PRO) {
            LAS float* scr = (LAS float*)(lds + wave * 16384);
            const float* hg_w_in = (const float*)ldp(lds, 2); const float* hg_w_out = (const float*)ldp(lds, 5); const float* att_w_in = (const float*)ldp(lds, 6); const float* att_w_out = (const float*)ldp(lds, 7);
            constexpr int I_A = (DM / 64) * (HG_COLS / 32), I_B = (DI / 64) * (DM / 32), I_C = (DM / 64) * (ATT_COLS / 32), I_D = I_B;
            for (int it = gw; it < I_A + I_B + I_C + I_D; it += NGW) {
                int r = it;
                if (r < I_A) { p0_transpose_item(hg_w_in, DM, HG_COLS, Whgin, scr, r, lane); continue; } r -= I_A;
                if (r < I_B) { p0_transpose_item(hg_w_out, DI, DM, Whgout, scr, r, lane); continue; } r -= I_B;
                if (r < I_C) { p0_transpose_item(att_w_in, DM, ATT_COLS, Wattin, scr, r, lane); continue; } r -= I_C;
                p0_transpose_item(att_w_out, DI, DM, Wattout, scr, r, lane);
            }
            for (int m = gw; m < T; m += NGW) rms_row_to_bf16(x + (size_t)m * DM, ln_g, U0 + (size_t)m * DM, lane);
        } else if (ph == PH_G1_0 || ph == PH_G1_1) {
            const int b = (ph == PH_G1_1);
            const pg8::Gemm g{U0 + (size_t)b * SEQ * DM, Whgin, SEQ, HG_COLS, DM}; const pg8::EpiBf16 E{QFIG, HG_COLS, 0, 1.0f};
            pg8::StaticOrder S; S.init(SEQ, HG_COLS, G, bx);
            pg8::gemm_phase<pg8::EpiBf16, pg8::StaticOrder, PG8_ALIGN, PG8_SP2>(lds, g, S, E);
        } else if (ph >= PH_G3_0 && ph < PH_GATE && ((ph - PH_G3_0) & 1) == 0) {
            const int k = (ph - PH_G3_0) >> 1, gi = k >> 1, b = k & 1;
            const pg8::Gemm g{U1 + (size_t)b * SEQ * DM, Wattin + (size_t)gi * QKV_COLS * DM, SEQ, QKV_COLS, DM}; const pg8::EpiBf16 E{QKV, QKV_COLS, FAST_ATT ? DI : 0, QSCALE};
            pg8::StaticOrder S; S.init(SEQ, QKV_COLS, G, bx);
            pg8::gemm_phase<pg8::EpiBf16, pg8::StaticOrder, PG8_ALIGN, PG8_SP2>(lds, g, S, E);
        } else if (ph == PH_G2 || ph == PH_G5) {
            pg8::Gemm g{YB, ph == PH_G2 ? Whgout : Wattout, T, DM, DI};
            pg8::EpiResF32 E{ph == PH_G2 ? x : Hres, Hres, DM};
            pg8::StaticOrder S; S.init(T, DM, G, bx);
            pg8::gemm_phase<pg8::EpiResF32, pg8::StaticOrder, PG8_ALIGN, PG8_SP2>(lds, g, S, E);
        } else if (ph == PH_GATE) {
            pg8::Gemm g{U1, Wattin + (size_t)3 * QKV_COLS * DM, T, DI, DM};
            pg8::EpiGateMul E{YB, DI};
            pg8::StaticOrder S; S.init(T, DI, G, bx);
            pg8::gemm_phase<pg8::EpiGateMul, pg8::StaticOrder, PG8_ALIGN, PG8_SP2>(lds, g, S, E);
        } else if (ph == PH_HGA_0 || ph == PH_HGA_1 || ph == PH_HGB_0 || ph == PH_HGB_1) {
            const int b = (ph >= PH_G1_1); const bool outp = (ph == PH_HGB_0 || ph == PH_HGB_1);
            const float* lbl = (const float*)ldp(lds, 3); const float* ngp = (const float*)ldp(lds, 4);
#if FAST_HG
            float* Ust = (float*)(ws + WS_HGU); float* Ast = (float*)(ws + WS_HGA);
            for (int item = vcu; item < 256; item += G) {
                if (outp) hgrn_pass<true>(lds, item, tid, QFIG, lbl, ngp, Ust, Ast, YB + (size_t)b * SEQ * DI);
                else hgrn_pass<false>(lds, item, tid, QFIG, lbl, ngp, Ust, Ast, YB + (size_t)b * SEQ * DI);
            }
#else
            if (!outp && vcu < 16) naive_hgrn(lds, vcu, tid & 127, tid < 128, QFIG, lbl, ngp, YB + (size_t)b * SEQ * DI);
#endif
        } else if (ph >= PH_G3_0 && ph < PH_GATE && ((ph - PH_G3_0) & 1) == 1) {
            const int k = (ph - PH_G3_0) >> 1, gi = k >> 1, b = k & 1;
#if FAST_ATT
            attn_phase(lds, vcu, G, tid, QKV, (const float*)ldp(lds, 8), YB + (size_t)b * SEQ * DI, (float*)(ws + WS_LSE) + (size_t)b * SEQ * 16, gi);
#else
            for (int idx = bx * (NWAVES * 64) + tid; idx < SEQ * 16; idx += G * NWAVES * 64)
                naive_attn(idx, QKV, (const float*)ldp(lds, 8), YB + (size_t)b * SEQ * DI, (float*)(ws + WS_LSE) + (size_t)b * SEQ * 16, gi);
#endif
        } else if (ph == PH_NORM1) {
            for (int m = gw; m < T; m += NGW) rms_row_to_bf16(Hres + (size_t)m * DM, ln_g + DM, U1 + (size_t)m * DM, lane);
        } else if (ph == PH_FINAL) {
            for (int m = gw; m < T; m += NGW) rms_row_inplace_f32(Hres + (size_t)m * DM, (const float*)ldp(lds, 9), lane);
        }
        if (ph + 1 < ph_hi) grid.sync();
    }
}

extern "C" void kernel_launch(void* const* d_in, const int* in_sizes, int n_in, void* d_out, int out_size, void* d_ws, size_t ws_size, hipStream_t stream) {
    static int grid = 0;
    if (grid == 0) {
        if (n_in != 10 || out_size != T * DM || ws_size < WS_END) { fprintf(stderr, "kernel_launch: unexpected shapes (n_in %d out %d ws %zu)\n", n_in, out_size, ws_size); grid = -1; return; }
        int dev = 0, cus = 0, per_cu = 0;
        hipGetDevice(&dev); hipDeviceGetAttribute(&cus, hipDeviceAttributeMultiprocessorCount, dev);
        if (hipFuncSetAttribute((const void*)fwd, hipFuncAttributeMaxDynamicSharedMemorySize, LDS_BYTES) != hipSuccess) { fprintf(stderr, "kernel_launch: hipFuncSetAttribute failed\n"); grid = -1; return; }
        hipOccupancyMaxActiveBlocksPerMultiprocessor(&per_cu, (const void*)fwd, NWAVES * 64, LDS_BYTES);
        if (per_cu < 1) { fprintf(stderr, "kernel_launch: occupancy query reports %d blocks per CU\n", per_cu); per_cu = 1; }
        (void)hipGetLastError();
        grid = cus * per_cu;
    }
    if (grid < 0) return;
    Args a{};
    for (int i = 0; i < 10; ++i) a.in[i] = (const float*)d_in[i];
    a.out = (float*)d_out; a.ws = (unsigned char*)d_ws;
    a.lo = PH_PRO; a.hi = PH_END;
    void* kargs[] = {&a};
    const hipError_t le = hipLaunchCooperativeKernel((const void*)fwd, dim3(grid), dim3(NWAVES * 64), kargs, LDS_BYTES, stream);
    if (le != hipSuccess) fprintf(stderr, "kernel_launch: cooperative launch failed: %s (grid %d)\n", hipGetErrorString(le), grid);
}
```

```cpp
#include <hip/hip_runtime.h>
#include <hip/hip_cooperative_groups.h>
#include <cstdio>
#include <cstdint>
namespace cg = cooperative_groups;
namespace pg8 {
#define PG8_LAS __attribute__((address_space(3)))
typedef unsigned short bf16_t;
typedef short bf16x8 __attribute__((ext_vector_type(8)));
typedef float f32x4 __attribute__((ext_vector_type(4)));
typedef unsigned u32x4 __attribute__((ext_vector_type(4)));
constexpr int BM = 256, BK = 64, HALF = 128, HTB = HALF * BK * 2  , STAGE_BYTES = 8 * HTB, NXCD = 8, WGM = 8;

__host__ __device__ __forceinline__ int lds_byte(int r, int c) { const int st = (r >> 4) * 2 + (c >> 5), rr = r & 15, cc = c & 31, ob = rr * 64 + cc * 2; return st * 1024 + (ob ^ (((ob >> 9) & 1) << 5)); }
__host__ __device__ __forceinline__ void stage_rc(int b, int& R, int& C) { const int st = b / 1024, sb = b % 1024, swz = sb ^ (((sb >> 9) & 1) << 5); R = (st >> 1) * 16 + swz / 64; C = (st & 1) * 32 + (swz % 64) / 2; }
__host__ __device__ __forceinline__ int perm32(int rho) { const int n = rho >> 4, i = rho & 15; return 8 * (i >> 2) + 4 * n + (i & 3); }

struct Unit { int pm, pn; };
#define PG8_GAS __attribute__((address_space(1)))
struct Gemm { const PG8_GAS bf16_t* A; const PG8_GAS bf16_t* Bt; int M, N, K; };

struct StaticOrder {
    int nM, nN, nwg, G, c;
    __host__ __device__ void init(int M, int N, int G_, int c_) { nM = M / BM; nN = N / BM; nwg = nM * nN; G = G_; c = c_; }
    __host__ __device__ bool next(int i, Unit& u) const {
        const long L = (long)i * G + c; if (L >= nwg) return false;
        int wgid = (int)L; { const int q = nwg / NXCD, r = nwg % NXCD, xcd = wgid % NXCD, off = wgid / NXCD; wgid = (xcd < r ? xcd * (q + 1) : r * (q + 1) + (xcd - r) * q) + off; }
        const int nig = WGM * nN, gid = wgid / nig, fm = gid * WGM, gsz = (nM - fm) < WGM ? (nM - fm) : WGM;
        u.pm = fm + ((wgid % nig) % gsz); u.pn = (wgid % nig) / gsz; return true;
    }
    __device__ __forceinline__ void a_ready(const Unit&) const {}
    __device__ __forceinline__ void done(const Unit&) const {}
};

__device__ __forceinline__ unsigned cvt_pk_bf16(float lo, float hi) { unsigned r; asm volatile("v_cvt_pk_bf16_f32 %0, %1, %2" : "=v"(r) : "v"(lo), "v"(hi)); return r; }
__device__ __forceinline__ float bf_lo(unsigned w) { return __uint_as_float(w << 16); }
__device__ __forceinline__ float bf_hi(unsigned w) { return __uint_as_float(w & 0xffff0000u); }
struct EpiBf16 {
    static constexpr bool PERM = true, AFTER_DRAIN = false;
    PG8_GAS bf16_t* O; int ldc; int qcols; float qscale;
    __device__ __forceinline__ void operator()(const f32x4 (&acc)[2][2][4][2], const Unit& u, int wr, int wc, int fr, int fq) const {
        const int row0 = u.pm * BM + wr * 64 + fr, col0 = u.pn * BM + wc * 32 + 8 * fq;
        const float sc = (u.pn * BM < qcols) ? qscale : 1.0f;
#pragma unroll
        for (int ai = 0; ai < 2; ++ai)
#pragma unroll
            for (int m = 0; m < 4; ++m) { PG8_GAS bf16_t* rowp = O + (size_t)(row0 + ai * HALF + m * 16) * ldc + col0;
#pragma unroll
                for (int bj = 0; bj < 2; ++bj) { const f32x4 v0 = acc[ai][bj][m][0] * sc, v1 = acc[ai][bj][m][1] * sc;
                    u32x4 w; w.x = cvt_pk_bf16(v0[0], v0[1]); w.y = cvt_pk_bf16(v0[2], v0[3]); w.z = cvt_pk_bf16(v1[0], v1[1]); w.w = cvt_pk_bf16(v1[2], v1[3]);
                    *(PG8_GAS u32x4*)(rowp + bj * HALF) = w; } }
    }
};
struct EpiResF32 {
    static constexpr bool PERM = false, AFTER_DRAIN = false;
    const PG8_GAS float* base; PG8_GAS float* out; int ldc;
    __device__ __forceinline__ void operator()(const f32x4 (&acc)[2][2][4][2], const Unit& u, int wr, int wc, int fr, int fq) const {
        const int row0 = u.pm * BM + wr * 64 + fr, col0 = u.pn * BM + wc * 32 + 4 * fq;
#pragma unroll
        for (int ai = 0; ai < 2; ++ai)
#pragma unroll
            for (int m = 0; m < 4; ++m) { const size_t off = (size_t)(row0 + ai * HALF + m * 16) * ldc + col0;
#pragma unroll
                for (int bj = 0; bj < 2; ++bj)
#pragma unroll
                    for (int n = 0; n < 2; ++n) { const f32x4 b = *(const PG8_GAS f32x4*)(base + off + bj * HALF + n * 16); *(PG8_GAS f32x4*)(out + off + bj * HALF + n * 16) = b + acc[ai][bj][m][n]; } }
    }
};
struct EpiGateMul {
    static constexpr bool PERM = true, AFTER_DRAIN = false;
    PG8_GAS bf16_t* O; int ldc;
    __device__ __forceinline__ float sg(float o, float g) const { return o * g / (1.0f + __expf(-g)); }
    __device__ __forceinline__ void operator()(const f32x4 (&acc)[2][2][4][2], const Unit& u, int wr, int wc, int fr, int fq) const {
        const int row0 = u.pm * BM + wr * 64 + fr, col0 = u.pn * BM + wc * 32 + 8 * fq;
#pragma unroll
        for (int ai = 0; ai < 2; ++ai)
#pragma unroll
            for (int m = 0; m < 4; ++m) { PG8_GAS bf16_t* rowp = O + (size_t)(row0 + ai * HALF + m * 16) * ldc + col0;
#pragma unroll
                for (int bj = 0; bj < 2; ++bj) { const f32x4 v0 = acc[ai][bj][m][0], v1 = acc[ai][bj][m][1];
                    const u32x4 ov = *(const PG8_GAS u32x4*)(rowp + bj * HALF);
                    u32x4 w; w.x = cvt_pk_bf16(sg(bf_lo(ov.x), v0[0]), sg(bf_hi(ov.x), v0[1])); w.y = cvt_pk_bf16(sg(bf_lo(ov.y), v0[2]), sg(bf_hi(ov.y), v0[3]));
                    w.z = cvt_pk_bf16(sg(bf_lo(ov.z), v1[0]), sg(bf_hi(ov.z), v1[1])); w.w = cvt_pk_bf16(sg(bf_lo(ov.w), v1[2]), sg(bf_hi(ov.w), v1[3]));
                    *(PG8_GAS u32x4*)(rowp + bj * HALF) = w; } }
    }
};
template <class Epi, class Sched, bool ALIGN_EPI = false, bool SP2 = false>
__device__ __forceinline__ void gemm_phase(PG8_LAS unsigned char* lds, const Gemm g, const Sched& S, const Epi& E) {
    int tid_ = threadIdx.x; asm volatile("" : "+v"(tid_));
    const int tid = tid_, wid = __builtin_amdgcn_readfirstlane(tid >> 6), lane = tid & 63, wr = wid >> 2, wc = wid & 3, fr = lane & 15, fq = lane >> 4;
    const int K = g.K, nt = K / BK;
    unsigned voffA[2], voffB[2];
#pragma unroll
    for (int i = 0; i < 2; ++i) { int R, C; stage_rc(tid * 16 + i * 8192, R, C); const int Rb = Epi::PERM ? ((R & ~31) + perm32(R & 31)) : R;
        voffA[i] = (unsigned)(R * K + C) * 2u; voffB[i] = (unsigned)(Rb * K + C) * 2u; }
    const size_t kstep = (size_t)(BK * 2);
    const size_t hstep = (size_t)HALF * K * 2;
    const size_t tstep = 2 * hstep;
    const unsigned ldsw = (unsigned)wid * 1024u;
    const int aoff = lds_byte(wr * 64 + fr, fq * 8), boff = lds_byte(wc * 32 + fr, fq * 8);
#define PG8_SA(b, h) (((b) * 2 + (h)) * HTB)
#define PG8_SB(b, h) ((4 + (b) * 2 + (h)) * HTB)
#define PG8_STAGE(bufoff, gbase, voff) do { _Pragma("unroll") for (int _i = 0; _i < 2; ++_i) \
        __builtin_amdgcn_global_load_lds((const PG8_GAS unsigned*)((const PG8_GAS char*)(gbase) + (voff)[_i]), (PG8_LAS unsigned*)(lds + (bufoff) + ldsw + _i * 8192), 16, 0, 0); } while (0)
#define PG8_LDA(dst, b, h) do { _Pragma("unroll") for (int m = 0; m < 4; ++m) _Pragma("unroll") for (int k = 0; k < 2; ++k) dst[m][k] = *(const PG8_LAS bf16x8*)(lds + PG8_SA(b, h) + aoff + m * 2048 + k * 1024); } while (0)
#define PG8_LDB(dst, b, h) do { _Pragma("unroll") for (int n = 0; n < 2; ++n) _Pragma("unroll") for (int k = 0; k < 2; ++k) dst[n][k] = *(const PG8_LAS bf16x8*)(lds + PG8_SB(b, h) + boff + n * 2048 + k * 1024); } while (0)
#define PG8_MMA(ai, bj, At, Bt) do { __builtin_amdgcn_s_setprio(1); _Pragma("unroll") for (int m = 0; m < 4; ++m) _Pragma("unroll") for (int n = 0; n < 2; ++n) _Pragma("unroll") for (int k = 0; k < 2; ++k) \
        acc[ai][bj][m][n] = __builtin_amdgcn_mfma_f32_16x16x32_bf16(Bt[n][k], At[m][k], acc[ai][bj][m][n], 0, 0, 0); __builtin_amdgcn_s_setprio(0); } while (0)
#define PG8_WAIT_V(n) asm volatile("s_waitcnt vmcnt(" #n ")" ::: "memory")
#define PG8_WAIT_L(n) asm volatile("s_waitcnt lgkmcnt(" #n ")" ::: "memory")
#define PG8_BAR __builtin_amdgcn_s_barrier()
#define PG8_SCHED __builtin_amdgcn_sched_barrier(0)
    Unit cur, nxt; int ui = 0;
    if (!S.next(0, cur)) return;
    f32x4 acc[2][2][4][2];
#pragma unroll
    for (int a = 0; a < 2; ++a)
#pragma unroll
        for (int b = 0; b < 2; ++b)
#pragma unroll
            for (int m = 0; m < 4; ++m)
#pragma unroll
                for (int n = 0; n < 2; ++n) acc[a][b][m][n] = (f32x4){0.f, 0.f, 0.f, 0.f};
    bf16x8 At[4][2], B0[2][2], B1[2][2];
    const PG8_GAS char* cA = (const PG8_GAS char*)g.A + (size_t)cur.pm * tstep; const PG8_GAS char* cB = (const PG8_GAS char*)g.Bt + (size_t)cur.pn * tstep;
    S.a_ready(cur);
    if constexpr (SP2) {
        PG8_STAGE(PG8_SB(0, 0), cB, voffB); PG8_STAGE(PG8_SB(0, 1), cB + hstep, voffB); PG8_STAGE(PG8_SA(0, 0), cA, voffA); PG8_STAGE(PG8_SA(0, 1), cA + hstep, voffA);
        if (wr == 1) PG8_BAR;
        PG8_WAIT_V(2); PG8_BAR;
        PG8_STAGE(PG8_SB(1, 0), cB + kstep, voffB); PG8_STAGE(PG8_SA(1, 0), cA + kstep, voffA); PG8_STAGE(PG8_SB(1, 1), cB + hstep + kstep, voffB);
        PG8_WAIT_V(6); PG8_BAR;
    } else {
        PG8_STAGE(PG8_SB(0, 0), cB, voffB); PG8_STAGE(PG8_SA(0, 0), cA, voffA); PG8_STAGE(PG8_SB(0, 1), cB + hstep, voffB); PG8_STAGE(PG8_SA(0, 1), cA + hstep, voffA);
        if (wr == 1) PG8_BAR;
        PG8_WAIT_V(4); PG8_BAR;
        PG8_STAGE(PG8_SB(1, 0), cB + kstep, voffB); PG8_STAGE(PG8_SA(1, 0), cA + kstep, voffA); PG8_STAGE(PG8_SB(1, 1), cB + hstep + kstep, voffB);
        PG8_WAIT_V(6); PG8_BAR;
    }
    for (;;) {
        const bool has_next = S.next(ui + 1, nxt);
        const PG8_GAS char* nA = has_next ? (const PG8_GAS char*)g.A + (size_t)nxt.pm * tstep : cA; const PG8_GAS char* nB = has_next ? (const PG8_GAS char*)g.Bt + (size_t)nxt.pn * tstep : cB;
        for (int t = 0; t < nt; t += 2) {
            const bool last = (t == nt - 2);
            const PG8_GAS char* a1 = cA + (size_t)(t + 1) * kstep;
            const PG8_GAS char* a2 = last ? nA : cA + (size_t)(t + 2) * kstep; const PG8_GAS char* b2 = last ? nB : cB + (size_t)(t + 2) * kstep;
            const PG8_GAS char* a3 = a2 + kstep; const PG8_GAS char* b3 = b2 + kstep;
            if (last && has_next) S.a_ready(nxt);
            if constexpr (SP2) {
            PG8_LDB(B0, 0, 0); PG8_LDB(B1, 0, 1); PG8_SCHED; PG8_LDA(At, 0, 0); PG8_STAGE(PG8_SA(1, 1), a1 + hstep, voffA);
            PG8_WAIT_V(8); PG8_WAIT_L(0); PG8_BAR; PG8_MMA(0, 0, At, B0); PG8_MMA(0, 1, At, B1); PG8_BAR; PG8_SCHED;
            PG8_LDA(At, 0, 1); PG8_STAGE(PG8_SB(0, 0), b2, voffB); PG8_STAGE(PG8_SB(0, 1), b2 + hstep, voffB); PG8_STAGE(PG8_SA(0, 0), a2, voffA);
            PG8_WAIT_V(8); PG8_WAIT_L(0); PG8_BAR; PG8_MMA(1, 0, At, B0); PG8_MMA(1, 1, At, B1); PG8_BAR; PG8_SCHED;
            PG8_LDB(B0, 1, 0); PG8_LDB(B1, 1, 1); PG8_SCHED; PG8_LDA(At, 1, 0); PG8_STAGE(PG8_SA(0, 1), a2 + hstep, voffA);
            PG8_WAIT_V(8); PG8_WAIT_L(0); PG8_BAR; PG8_MMA(0, 0, At, B0); PG8_MMA(0, 1, At, B1); PG8_BAR; PG8_SCHED;
            PG8_LDA(At, 1, 1); PG8_STAGE(PG8_SB(1, 0), b3, voffB); PG8_STAGE(PG8_SB(1, 1), b3 + hstep, voffB); PG8_STAGE(PG8_SA(1, 0), a3, voffA);
            PG8_WAIT_V(8); PG8_WAIT_L(0); PG8_BAR; PG8_MMA(1, 0, At, B0); PG8_MMA(1, 1, At, B1); PG8_BAR; PG8_SCHED;
            } else {
            PG8_LDB(B0, 0, 0); PG8_SCHED; PG8_LDA(At, 0, 0); PG8_STAGE(PG8_SA(1, 1), a1 + hstep, voffA);
            PG8_WAIT_L(8); PG8_BAR; PG8_WAIT_L(0); PG8_MMA(0, 0, At, B0); PG8_BAR; PG8_SCHED;
            PG8_LDB(B1, 0, 1); PG8_STAGE(PG8_SB(0, 0), b2, voffB);
            PG8_BAR; PG8_WAIT_L(0); PG8_MMA(0, 1, At, B1); PG8_BAR;
            PG8_LDA(At, 0, 1); PG8_STAGE(PG8_SA(0, 0), a2, voffA);
            PG8_BAR; PG8_WAIT_L(0); PG8_MMA(1, 0, At, B0); PG8_BAR; PG8_SCHED;
            PG8_STAGE(PG8_SB(0, 1), b2 + hstep, voffB);
            PG8_WAIT_V(6); PG8_BAR; PG8_MMA(1, 1, At, B1); PG8_BAR;
            PG8_LDB(B0, 1, 0); PG8_SCHED; PG8_LDA(At, 1, 0); PG8_STAGE(PG8_SA(0, 1), a2 + hstep, voffA);
            PG8_WAIT_L(8); PG8_BAR; PG8_WAIT_L(0); PG8_MMA(0, 0, At, B0); PG8_BAR; PG8_SCHED;
            PG8_LDB(B1, 1, 1); PG8_STAGE(PG8_SB(1, 0), b3, voffB);
            PG8_BAR; PG8_WAIT_L(0); PG8_MMA(0, 1, At, B1); PG8_BAR;
            PG8_LDA(At, 1, 1); PG8_STAGE(PG8_SA(1, 0), a3, voffA);
            PG8_BAR; PG8_WAIT_L(0); PG8_MMA(1, 0, At, B0); PG8_BAR; PG8_SCHED;
            PG8_STAGE(PG8_SB(1, 1), b3 + hstep, voffB);
            PG8_WAIT_V(6); PG8_BAR; PG8_MMA(1, 1, At, B1); PG8_BAR;
            }
        }
        if constexpr (ALIGN_EPI) { if (wr == 0) PG8_BAR; }
        if constexpr (!Epi::AFTER_DRAIN) { E(acc, cur, wr, wc, fr, fq); S.done(cur); }
        if (!has_next) break;
#pragma unroll
        for (int a = 0; a < 2; ++a)
#pragma unroll
            for (int b = 0; b < 2; ++b)
#pragma unroll
                for (int m = 0; m < 4; ++m)
#pragma unroll
                    for (int n = 0; n < 2; ++n) acc[a][b][m][n] = (f32x4){0.f, 0.f, 0.f, 0.f};
        cur = nxt; cA = nA; cB = nB; ++ui;
        if constexpr (ALIGN_EPI) { if (wr == 1) PG8_BAR; }
    }
    PG8_WAIT_V(0);
    if constexpr (!ALIGN_EPI) { if (wr == 0) PG8_BAR; }
    PG8_BAR;
    if constexpr (Epi::AFTER_DRAIN) { E.fused(acc, cur, wr, wc, fr, fq, lds, wid, lane); S.done(cur); }
#undef PG8_SA
#undef PG8_SB
#undef PG8_STAGE
#undef PG8_LDA
#undef PG8_LDB
#undef PG8_MMA
#undef PG8_WAIT_V
#undef PG8_WAIT_L
#undef PG8_BAR
#undef PG8_SCHED
}
}
#ifndef PG8_SP2
#define PG8_SP2 true
#endif
#ifndef PG8_ALIGN
#define PG8_ALIGN true
#endif
constexpr int NWAVES = 8;
constexpr int BATCH = 2, SEQ = 16384, DM = 1024, DI = 2048, T = BATCH * SEQ;
constexpr int HG_COLS = 4 * DI;
constexpr int ATT_COLS = 10 * DI;
constexpr int QKV_COLS = 3 * DI;
constexpr float EPS = 1e-6f;
constexpr size_t MiB = 1u << 20;
constexpr size_t WS_CTL = 0;
constexpr size_t WS_WHGIN = 1 * MiB, WS_WHGOUT = 17 * MiB, WS_WATTIN = 21 * MiB, WS_WATTOUT = 61 * MiB;
constexpr size_t WS_LSE = 65 * MiB;
constexpr size_t WS_BIG0 = 96 * MiB;
constexpr size_t WS_U1 = WS_BIG0, WS_QKV = WS_BIG0 + 64 * MiB;
constexpr size_t WS_BIG1 = 352 * MiB;
constexpr size_t WS_END = 480 * MiB;
constexpr int RING_BYTES = 131072;
constexpr int LDS_BYTES = 155648;
constexpr int TAB_OFF = 153600;
enum { PH_PRO = 0, PH_G1_0 = 1, PH_HGA_0 = 2, PH_HGB_0 = 3, PH_G1_1 = 4, PH_HGA_1 = 5, PH_HGB_1 = 6, PH_G2 = 7, PH_NORM1 = 8, PH_G3_0 = 9  , PH_GATE = 21, PH_G5 = 22, PH_FINAL = 23, PH_END = 24 };

#define LAS __attribute__((address_space(3)))
#define GAS __attribute__((address_space(1)))
typedef unsigned short bf16;
typedef unsigned v4u __attribute__((ext_vector_type(4)));
typedef float f32x4 __attribute__((ext_vector_type(4)));
#define LDS_WAIT() asm volatile("s_waitcnt lgkmcnt(0)" ::: "memory")
__device__ __forceinline__ unsigned f2bf(float f) { unsigned u = __builtin_bit_cast(unsigned, f); return (u + 0x7fffu + ((u >> 16) & 1u)) >> 16; }
__device__ __forceinline__ unsigned pk2(float lo, float hi) { return f2bf(lo) | (f2bf(hi) << 16); }
__device__ __forceinline__ float bf2f(unsigned short b) { return __uint_as_float(((unsigned)b) << 16); }
__device__ __forceinline__ float blo(unsigned w) { return __uint_as_float(w << 16); }
__device__ __forceinline__ float bhi(unsigned w) { return __uint_as_float(w & 0xffff0000u); }
__device__ __forceinline__ float wave_sum(float v) {
#pragma unroll
    for (int o = 1; o < 64; o <<= 1) v += __shfl_xor(v, o);
    return v;
}
__device__ const unsigned char BUCKET[3][129] = {
{0,1,2,3,4,5,6,7,8,9,10,11,12,13,14,15,16,16,16,16,16,16,17,17,17,17,17,17,17,17,18,18,18,18,18,18,18,18,18,18,19,19,19,19,19,19,19,19,19,19,19,19,19,19,20,20,20,20,20,20,20,20,20,20,20,20,20,20,20,20,20,20,20,21,21,21,21,21,21,21,21,21,21,21,21,21,21,21,21,21,21,21,21,21,21,21,21,21,21,22,22,22,22,22,22,22,22,22,22,22,22,22,22,22,22,22,22,22,22,22,22,22,22,22,22,22,22,22,22},
{0,4,8,12,16,16,17,17,18,18,19,19,19,19,20,20,20,20,20,21,21,21,21,21,21,22,22,22,22,22,22,22,22,22,23,23,23,23,23,23,23,23,23,23,23,23,24,24,24,24,24,24,24,24,24,24,24,24,24,24,24,24,25,25,25,25,25,25,25,25,25,25,25,25,25,25,25,25,25,25,25,25,25,26,26,26,26,26,26,26,26,26,26,26,26,26,26,26,26,26,26,26,26,26,26,26,26,26,26,26,26,26,26,27,27,27,27,27,27,27,27,27,27,27,27,27,27,27,27},
{0,16,18,19,20,21,21,22,22,23,23,23,24,24,24,24,25,25,25,25,25,26,26,26,26,26,26,26,26,27,27,27,27,27,27,27,27,27,27,28,28,28,28,28,28,28,28,28,28,28,28,28,29,29,29,29,29,29,29,29,29,29,29,29,29,29,29,29,29,29,30,30,30,30,30,30,30,30,30,30,30,30,30,30,30,30,30,30,30,30,30,30,30,30,30,31,31,31,31,31,31,31,31,31,31,31,31,31,31,31,31,31,31,31,31,31,31,31,31,31,31,31,31,31,31,31,31,31,31}};

__device__ __forceinline__ void p0_transpose_item(const GAS float* W, int K, int N, GAS bf16* WT, LAS float* scr, int item, int lane) {
    const int nblk = N / 32, kb = item / nblk, nb = item % nblk, k0 = 64 * kb, n0 = 32 * nb;
#pragma unroll 8
    for (int i = 0; i < 32; ++i) { const int kk = 2 * i + (lane >> 5); scr[kk * 33 + (lane & 31)] = W[(size_t)(k0 + kk) * N + n0 + (lane & 31)]; }
    LDS_WAIT(); asm volatile("" ::: "memory");
    const int c = lane & 7;
#pragma unroll
    for (int j = 0; j < 4; ++j) { const int n = (lane >> 3) + 8 * j; const LAS float* s = scr + (8 * c) * 33 + n;
        v4u o; o.x = pk2(s[0 * 33], s[1 * 33]); o.y = pk2(s[2 * 33], s[3 * 33]); o.z = pk2(s[4 * 33], s[5 * 33]); o.w = pk2(s[6 * 33], s[7 * 33]);
        *(GAS v4u*)(WT + (size_t)(n0 + n) * K + k0 + 8 * c) = o; }
    LDS_WAIT(); asm volatile("" ::: "memory");
}
__device__ __forceinline__ void rms_row_to_bf16(const GAS float* xrow, const GAS float* g, GAS bf16* orow, int lane) {
    const GAS f32x4* xr = (const GAS f32x4*)xrow + lane; const GAS f32x4* gr = (const GAS f32x4*)g + lane;
    f32x4 v[4]; float s = 0.f;
#pragma unroll
    for (int j = 0; j < 4; ++j) { v[j] = xr[64 * j]; s += (v[j].x * v[j].x + v[j].y * v[j].y) + (v[j].z * v[j].z + v[j].w * v[j].w); }
    const float rs = 1.0f / sqrtf(wave_sum(s) * (1.0f / DM) + EPS);
    GAS unsigned long long* o8 = (GAS unsigned long long*)orow + lane;
#pragma unroll
    for (int j = 0; j < 4; ++j) { const f32x4 gv = gr[64 * j]; const f32x4 o = v[j] * rs * gv;
        o8[64 * j] = (unsigned long long)pk2(o.x, o.y) | ((unsigned long long)pk2(o.z, o.w) << 32); }
}
__device__ __forceinline__ void rms_row_inplace_f32(GAS float* xrow, const GAS float* g, int lane) {
    GAS f32x4* xr = (GAS f32x4*)xrow + lane; const GAS f32x4* gr = (const GAS f32x4*)g + lane;
    f32x4 v[4]; float s = 0.f;
#pragma unroll
    for (int j = 0; j < 4; ++j) { v[j] = xr[64 * j]; s += (v[j].x * v[j].x + v[j].y * v[j].y) + (v[j].z * v[j].z + v[j].w * v[j].w); }
    const float rs = 1.0f / sqrtf(wave_sum(s) * (1.0f / DM) + EPS);
#pragma unroll
    for (int j = 0; j < 4; ++j) { const f32x4 gv = gr[64 * j]; xr[64 * j] = v[j] * rs * gv; }
}

#define RLX_AGENT __ATOMIC_RELAXED, __HIP_MEMORY_SCOPE_AGENT
#define XB_TMO      128
#define XB_XCNT(j)  (256  + 64 * (j))
#define XB_XSUB(j)  (1280 + 64 * (j))
#define XB_XGEN(j)  (2304 + 64 * (j))
#define XB_TOP      3328
#define XB_TOPGEN   3392
#define XCD_BAR_WORDS 3456
#define XB_SPIN_CAP (1u << 18)

__device__ __forceinline__ unsigned xb_ld(unsigned* p)              { return __hip_atomic_load(p, __ATOMIC_RELAXED, __HIP_MEMORY_SCOPE_AGENT); }
__device__ __forceinline__ unsigned xb_add(unsigned* p, unsigned v) { return __hip_atomic_fetch_add(p, v, __ATOMIC_RELAXED, __HIP_MEMORY_SCOPE_AGENT); }
__device__ __forceinline__ unsigned xb_xcc_id() { return (unsigned)__builtin_amdgcn_s_getreg((3 << 11) | 20) & 0xFu; }
#define XB_SPIN(cond, bar) do { unsigned _sp = 0; while (cond) { __builtin_amdgcn_s_sleep(1); \
    if ((++_sp & 255u) == 0u) { if (xb_ld(&(bar)[XB_TMO])) break; if (_sp > XB_SPIN_CAP) { atomicAdd(&(bar)[XB_TMO], 1u); break; } } } } while (0)

struct XcdBarrier {
    unsigned* bar; unsigned x;
    volatile LAS unsigned* st;
};

__device__ __forceinline__ XcdBarrier xcd_barrier_post(unsigned* bar, volatile LAS unsigned* st) {
    XcdBarrier b; b.bar = bar; b.x = xb_xcc_id(); b.st = st;
    if (threadIdx.x == 0) (void)xb_add(&bar[XB_XCNT(b.x)], 1u);
    return b;
}
__device__ __forceinline__ void xcd_barrier_complete(unsigned* bar, unsigned x, unsigned& nloc, unsigned& nx) {
    const unsigned G = gridDim.x * gridDim.y * gridDim.z;
    unsigned sum, cnt, mine, sp = 0u;
    for (;;) {
        sum = 0u; cnt = 0u; mine = 0u;
#pragma unroll
        for (unsigned j = 0; j < 16; ++j) { const unsigned c = xb_ld(&bar[XB_XCNT(j)]); sum += c; cnt += (c > 0u) ? 1u : 0u; mine = (j == x) ? c : mine; }
        if (sum == G) break;
        __builtin_amdgcn_s_sleep(1);
        if ((++sp & 255u) == 0u) { if (xb_ld(&bar[XB_TMO])) break; if (sp > XB_SPIN_CAP) { atomicAdd(&bar[XB_TMO], 1u); break; } }
    }
    nloc = mine > 0u ? mine : 1u; nx = cnt > 0u ? cnt : 1u;
}

__device__ __forceinline__ void xcd_barrier(const XcdBarrier& b) {
    asm volatile("s_waitcnt vmcnt(0)" ::: "memory");
    __syncthreads();
    if (threadIdx.x == 0) {
        unsigned* bar = b.bar;
        __builtin_amdgcn_s_waitcnt(0);
        unsigned nloc = b.st[0], nx = b.st[1];
        if (nloc == 0u) { xcd_barrier_complete(bar, b.x, nloc, nx); b.st[0] = nloc; b.st[1] = nx; }
        const unsigned old = xb_add(&bar[XB_XSUB(b.x)], 1u);
        const unsigned gen = old / nloc;
        if (old + 1u == (gen + 1u) * nloc) {
            __builtin_amdgcn_fence(__ATOMIC_RELEASE, "agent");
            asm volatile("s_waitcnt vmcnt(0)" ::: "memory");
            const unsigned og = xb_add(&bar[XB_TOP], 1u);
            const unsigned tg = og / nx;
            if (og + 1u == (tg + 1u) * nx) xb_add(&bar[XB_TOPGEN], 1u);
            else XB_SPIN(xb_ld(&bar[XB_TOPGEN]) == tg, bar);
            __builtin_amdgcn_fence(__ATOMIC_ACQUIRE, "agent");
            xb_add(&bar[XB_XGEN(b.x)], 1u);
            asm volatile("s_waitcnt vmcnt(0)" ::: "memory");
        } else {
            XB_SPIN(xb_ld(&bar[XB_XGEN(b.x)]) == gen, bar);
            __builtin_amdgcn_fence(__ATOMIC_ACQUIRE, "agent");
            asm volatile("s_waitcnt vmcnt(0)" ::: "memory");
        }
    }
    __syncthreads();
}

constexpr int CW_BAR = 1024;
constexpr size_t CTL_ZERO_BYTES = 32768;
#ifndef REPEAT_MASK
#define REPEAT_MASK 0u
#endif
typedef short bf16x8 __attribute__((ext_vector_type(8)));
typedef short s16x4 __attribute__((ext_vector_type(4)));
typedef float f32x16 __attribute__((ext_vector_type(16)));
typedef unsigned u32x2v __attribute__((ext_vector_type(2)));
__device__ __forceinline__ unsigned cvtpk(float lo, float hi) { unsigned r; asm volatile("v_cvt_pk_bf16_f32 %0, %1, %2" : "=v"(r) : "v"(lo), "v"(hi)); return r; }
__device__ __forceinline__ bf16x8 pack8(float a0, float a1, float a2, float a3, float a4, float a5, float a6, float a7) {
    v4u w; w.x = cvtpk(a0, a1); w.y = cvtpk(a2, a3); w.z = cvtpk(a4, a5); w.w = cvtpk(a6, a7); return __builtin_bit_cast(bf16x8, w);
}
__device__ __forceinline__ int crow(int r) { return (r & 3) + 8 * (r >> 2); }

constexpr int HG_QF = 0, HG_KIF = 8192, HG_KDF = 16384, HG_VF = 24576, HG_OB = 32768, HG_OBLD = 132, HG_TT = HG_OB + 32 * HG_OBLD * 4, HG_AD = HG_TT + 2048, HG_LDS_END = HG_AD + 512;
constexpr size_t WS_HGU = 67 * MiB, WS_HGA = 83 * MiB;
template <bool OUT>
__device__ __forceinline__ void hgrn_pass(LAS unsigned char* lds, int item, int tid, const GAS bf16* __restrict__ qfig, const GAS float* __restrict__ lb_logits, const GAS float* __restrict__ norm_g, GAS float* __restrict__ Ust, GAS float* __restrict__ Ast, GAS bf16* __restrict__ y) {
    const int h = item >> 4, J = item & 15;
    const int lane = tid & 63, w = __builtin_amdgcn_readfirstlane(tid >> 6), l15 = lane & 15, q4 = lane >> 4;
    const int col = tid & 127, cq = tid >> 7;
    const int eg = 16 * w + l15;
    float lb;
    { const int gc = h * 128 + col; const float l0 = lb_logits[gc], l1 = lb_logits[DI + gc], l2 = lb_logits[2 * DI + gc];
      const float mx = fmaxf(l0, fmaxf(l1, l2)); const float e0 = __expf(l0 - mx), e1 = __expf(l1 - mx), e2 = __expf(l2 - mx); lb = e0 / (e0 + e1 + e2); }
    f32x4 S[8];
#pragma unroll
    for (int dt = 0; dt < 8; ++dt) S[dt] = (f32x4){0.f, 0.f, 0.f, 0.f};
    if (OUT) {
        f32x4 P[8];
#pragma unroll
        for (int dt = 0; dt < 8; ++dt) P[dt] = (f32x4){1.f, 1.f, 1.f, 1.f};
        for (int Jp = J - 1; Jp >= 0; --Jp) { const GAS f32x4* Uf = (const GAS f32x4*)(Ust + (size_t)(h * 16 + Jp) * 16384) + (w * 8) * 64 + lane; const GAS float* Ab = Ast + (h * 16 + Jp) * 128;
            bool nz = false;
#pragma unroll
            for (int dt = 0; dt < 8; ++dt) { const f32x4 u = Uf[dt * 64]; const f32x4 a = *(const GAS f32x4*)(Ab + 16 * dt + 4 * q4); S[dt] += P[dt] * u; P[dt] *= a;
                nz = nz || (P[dt][0] != 0.f) || (P[dt][1] != 0.f) || (P[dt][2] != 0.f) || (P[dt][3] != 0.f); }
            if (!__any(nz)) break; }
    }
    float atot = 1.0f;
    const int pc = tid >> 4, pe = tid & 15;
    f32x4 ng0 = (f32x4){0.f, 0.f, 0.f, 0.f}, ng1 = ng0;
    if (OUT) { ng0 = *(const GAS f32x4*)(norm_g + h * 128 + 8 * pe); ng1 = *(const GAS f32x4*)(norm_g + h * 128 + 8 * pe + 4); }
    const GAS bf16* base = qfig + (size_t)(J * 1024) * HG_COLS + h * 128;
    unsigned short rq[8], rf[8], rv[8];
    { const GAS bf16* cb = base + (size_t)(8 * cq) * HG_COLS + col;
#pragma unroll
      for (int cc = 0; cc < 8; ++cc) { const GAS bf16* p = cb + (size_t)cc * HG_COLS; rf[cc] = p[DI]; rv[cc] = p[2 * DI]; rq[cc] = OUT ? p[0] : (unsigned short)0; } }
    for (int n = 0; n < 32; ++n) {
        v4u gw4 = (v4u){0u, 0u, 0u, 0u};
        if (OUT) gw4 = *(const GAS v4u*)(qfig + (size_t)(J * 1024 + n * 32 + pc) * HG_COLS + 3 * DI + h * 128 + 8 * pe);
        float qv[8], kv[8], cs[8]; unsigned short vraw[8];
#pragma unroll
        for (int cc = 0; cc < 8; ++cc) {
            const float fp = bf2f(rf[cc]); vraw[cc] = rv[cc]; qv[cc] = OUT ? bf2f(rq[cc]) : 0.f;
            const float f = lb + (1.0f - lb) * __builtin_amdgcn_rcpf(1.0f + __expf(-fp));
            kv[cc] = 1.0f - f; const float lf = __logf(f); cs[cc] = cc ? cs[cc - 1] + lf : lf; }
        { const int nn = (n < 31) ? n + 1 : n;
          const GAS bf16* cb = base + (size_t)(nn * 32 + 8 * cq) * HG_COLS + col;
#pragma unroll
          for (int cc = 0; cc < 8; ++cc) { const GAS bf16* p = cb + (size_t)cc * HG_COLS; rf[cc] = p[DI]; rv[cc] = p[2 * DI]; rq[cc] = OUT ? p[0] : (unsigned short)0; } }
        ((LAS float*)(lds + HG_TT))[cq * 128 + col] = cs[7];
        __syncthreads();
        { const LAS float* TT = (const LAS float*)(lds + HG_TT); const float T0 = TT[col], T1 = TT[128 + col], T2 = TT[256 + col], T3 = TT[384 + col];
          const float off = (cq > 0 ? T0 : 0.f) + (cq > 1 ? T1 : 0.f) + (cq > 2 ? T2 : 0.f); const float total = (T0 + T1) + (T2 + T3);
          const float adec = __expf(total); atot *= adec;
          if (cq == 0) ((LAS float*)(lds + HG_AD))[col] = adec;
          float kd[8];
          const int ks = col >> 5, tq = (col >> 2) & 3, jjd = 4 * ((col >> 4) & 1) + (col & 3);
#pragma unroll
          for (int cc = 0; cc < 8; ++cc) { const int c = 8 * cq + cc; const float b = off + cs[cc];
              kd[cc] = kv[cc] * __expf(total - b);
              if (OUT) { const float eb = __expf(b), enb = __expf(-b);
                  const int byte = c * 256 + (((ks * 4 + tq) ^ (c & 15)) * 16) + jjd * 2;
                  *(LAS unsigned short*)(lds + HG_QF + byte) = (unsigned short)f2bf(qv[cc] * eb);
                  *(LAS unsigned short*)(lds + HG_KIF + byte) = (unsigned short)f2bf(kv[cc] * enb); } }
          const int i4 = 4 * (cq >> 1), qa = 2 * (cq & 1), sw = (col >> 2) & 3;
          u32x2v w0, w1;
          w0.x = cvtpk(kd[0], kd[1]); w0.y = cvtpk(kd[2], kd[3]); w1.x = cvtpk(kd[4], kd[5]); w1.y = cvtpk(kd[6], kd[7]);
          *(LAS u32x2v*)(lds + HG_KDF + col * 64 + ((qa ^ sw) * 16) + i4 * 2) = w0;
          *(LAS u32x2v*)(lds + HG_KDF + col * 64 + (((qa + 1) ^ sw) * 16) + i4 * 2) = w1;
          w0.x = (unsigned)vraw[0] | ((unsigned)vraw[1] << 16); w0.y = (unsigned)vraw[2] | ((unsigned)vraw[3] << 16); w1.x = (unsigned)vraw[4] | ((unsigned)vraw[5] << 16); w1.y = (unsigned)vraw[6] | ((unsigned)vraw[7] << 16);
          *(LAS u32x2v*)(lds + HG_VF + col * 64 + ((qa ^ sw) * 16) + i4 * 2) = w0;
          *(LAS u32x2v*)(lds + HG_VF + col * 64 + (((qa + 1) ^ sw) * 16) + i4 * 2) = w1; }
        __syncthreads();
        const bf16x8 vfrag = *(const LAS bf16x8*)(lds + HG_VF + eg * 64 + ((q4 ^ ((eg >> 2) & 3)) * 16));
        if (OUT) {
            bf16x8 qf[2][4], kif[2][4];
#pragma unroll
            for (int jt = 0; jt < 2; ++jt)
#pragma unroll
                for (int ks = 0; ks < 4; ++ks) { const int c = 16 * jt + l15; const int byte = c * 256 + (((ks * 4 + q4) ^ (c & 15)) * 16);
                    qf[jt][ks] = *(const LAS bf16x8*)(lds + HG_QF + byte); kif[jt][ks] = *(const LAS bf16x8*)(lds + HG_KIF + byte); }
            f32x4 sc[2][2];
#pragma unroll
            for (int i = 0; i < 2; ++i)
#pragma unroll
                for (int jt = 0; jt < 2; ++jt) { sc[i][jt] = (f32x4){0.f, 0.f, 0.f, 0.f};
#pragma unroll
                    for (int ks = 0; ks < 4; ++ks) sc[i][jt] = __builtin_amdgcn_mfma_f32_16x16x32_bf16(kif[i][ks], qf[jt][ks], sc[i][jt], 0, 0, 0); }
            f32x4 o[2];
#pragma unroll
            for (int jt = 0; jt < 2; ++jt) { const int c = 16 * jt + l15; float pm[8];
#pragma unroll
                for (int r = 0; r < 4; ++r) { pm[r] = (4 * q4 + r <= c) ? sc[0][jt][r] : 0.f; pm[4 + r] = (16 + 4 * q4 + r <= c) ? sc[1][jt][r] : 0.f; }
                const bf16x8 pf = pack8(pm[0], pm[1], pm[2], pm[3], pm[4], pm[5], pm[6], pm[7]);
                o[jt] = __builtin_amdgcn_mfma_f32_16x16x32_bf16(pf, vfrag, (f32x4){0.f, 0.f, 0.f, 0.f}, 0, 0, 0); }
#pragma unroll
            for (int ks = 0; ks < 4; ++ks) { const bf16x8 sb = pack8(S[2 * ks][0], S[2 * ks][1], S[2 * ks][2], S[2 * ks][3], S[2 * ks + 1][0], S[2 * ks + 1][1], S[2 * ks + 1][2], S[2 * ks + 1][3]);
#pragma unroll
                for (int jt = 0; jt < 2; ++jt) o[jt] = __builtin_amdgcn_mfma_f32_16x16x32_bf16(qf[jt][ks], sb, o[jt], 0, 0, 0); }
#pragma unroll
            for (int jt = 0; jt < 2; ++jt)
#pragma unroll
                for (int r = 0; r < 4; ++r) ((LAS float*)(lds + HG_OB))[(16 * jt + 4 * q4 + r) * HG_OBLD + eg] = o[jt][r];
        }
#pragma unroll
        for (int dt = 0; dt < 8; ++dt) { const int d = 16 * dt + l15;
            const bf16x8 kdf = *(const LAS bf16x8*)(lds + HG_KDF + d * 64 + ((q4 ^ ((d >> 2) & 3)) * 16));
            const f32x4 av = *(const LAS f32x4*)(lds + HG_AD + (16 * dt + 4 * q4) * 4);
            S[dt] = __builtin_amdgcn_mfma_f32_16x16x32_bf16(kdf, vfrag, S[dt] * av, 0, 0, 0); }
        __syncthreads();
        if (OUT) {
            const LAS float* ob = (const LAS float*)(lds + HG_OB) + pc * HG_OBLD + 8 * pe;
            const f32x4 o0 = *(const LAS f32x4*)ob, o1 = *(const LAS f32x4*)(ob + 4);
            float ss = (o0.x * o0.x + o0.y * o0.y) + (o0.z * o0.z + o0.w * o0.w) + (o1.x * o1.x + o1.y * o1.y) + (o1.z * o1.z + o1.w * o1.w);
            ss += __shfl_xor(ss, 1); ss += __shfl_xor(ss, 2); ss += __shfl_xor(ss, 4); ss += __shfl_xor(ss, 8);
            const float rs = __builtin_amdgcn_rsqf(ss * (1.0f / 128.0f) + EPS);
            const size_t trow = (size_t)(J * 1024 + n * 32 + pc);
            const float g0 = blo(gw4.x), g1 = bhi(gw4.x), g2 = blo(gw4.y), g3 = bhi(gw4.y), g4 = blo(gw4.z), g5 = bhi(gw4.z), g6 = blo(gw4.w), g7 = bhi(gw4.w);
#define HG_Y(ov, gn, g) ((ov) * rs * (gn) * (g) * __builtin_amdgcn_rcpf(1.0f + __expf(-(g))))
            v4u yo; yo.x = cvtpk(HG_Y(o0.x, ng0.x, g0), HG_Y(o0.y, ng0.y, g1)); yo.y = cvtpk(HG_Y(o0.z, ng0.z, g2), HG_Y(o0.w, ng0.w, g3));
            yo.z = cvtpk(HG_Y(o1.x, ng1.x, g4), HG_Y(o1.y, ng1.y, g5)); yo.w = cvtpk(HG_Y(o1.z, ng1.z, g6), HG_Y(o1.w, ng1.w, g7));
#undef HG_Y
            *(GAS v4u*)(y + trow * DI + h * 128 + 8 * pe) = yo;
        }
    }
    if (!OUT) {
        GAS f32x4* Uf = (GAS f32x4*)(Ust + (size_t)(h * 16 + J) * 16384) + (w * 8) * 64 + lane;
#pragma unroll
        for (int dt = 0; dt < 8; ++dt) Uf[dt * 64] = S[dt];
        if (cq == 0) Ast[(h * 16 + J) * 128 + col] = atot;
    }
    __syncthreads();
}
constexpr int AT_RT = 0, AT_VT = 1024, AT_VROW = 320, AT_QT = 32 * AT_VROW, AT_VTB = AT_QT + 8192;
constexpr float LOG2E = 1.4426950408889634f, LN2 = 0.6931471805599453f;
constexpr float QSCALE = 0.08838834764831845f * LOG2E;
typedef short v4i16_t __attribute__((ext_vector_type(4)));
__device__ __forceinline__ s16x4 vtr(const LAS unsigned char* p) { return __builtin_bit_cast(s16x4, __builtin_amdgcn_ds_read_tr16_b64_v4i16((LAS v4i16_t*)p)); }
__device__ __forceinline__ void attn_phase(LAS unsigned char* lds, int vb, int G, int tid, const GAS bf16* __restrict__ qkv, const GAS float* __restrict__ rel_bias, GAS bf16* __restrict__ oacc, GAS float* __restrict__ lseacc, int g) {
    const int lane = tid & 63, w = __builtin_amdgcn_readfirstlane(tid >> 6), ql = lane & 31, hf = lane >> 5;
    const int ldil = 2 * g, dil = 1 << ldil, nqb = 512 >> ldil;
    LAS float* RT = (LAS float*)(lds + AT_RT);
    LAS unsigned char* VT = lds + AT_VT + w * AT_VTB;
    LAS unsigned char* QT = VT + AT_QT;
    const int i15 = lane & 15, gp = (lane >> 4) & 1;
    const LAS unsigned char* vtr_base = VT + (4 * hf + (i15 >> 2)) * AT_VROW + (16 * gp + 4 * (i15 & 3)) * 2;
    for (int it0 = vb * 32; it0 < 8192; it0 += G * 32) {
        const int h = it0 >> 9;
        __syncthreads();
        int t2 = tid; asm volatile("" : "+v"(t2));
        if (t2 < 191) { const int rel = 159 - t2; RT[t2] = (rel >= 0 && rel <= 128) ? rel_bias[(int)BUCKET[g][rel] * 48 + g * 16 + h] * LOG2E : -1e30f; }
        __syncthreads();
        const int itw = it0 + 4 * w; const int rres = (itw & 511) >> (9 - ldil), mbw = itw & (nqb - 1);
        const GAS bf16* kvbase = qkv + (size_t)rres * QKV_COLS + h * 128;
        const unsigned voffK = (unsigned)(ql * dil * QKV_COLS + 8 * hf) * 2u;
        const unsigned voffV = (unsigned)((lane >> 4) * dil * QKV_COLS + 8 * (lane & 15)) * 2u;
        const unsigned voffO = (unsigned)(ql * dil * DI + 4 * hf) * 2u;
        bf16x8 kf[8]; v4u vst[8];
#define AT_LOADK(kt_) do { const GAS char* kb_ = (const GAS char*)(kvbase + (size_t)(32 * (kt_) * dil) * QKV_COLS + DI); _Pragma("unroll") for (int ks = 0; ks < 8; ++ks) kf[ks] = *(const GAS bf16x8*)(kb_ + 32 * ks + voffK); } while (0)
#define AT_LOADV(kt_) do { const GAS char* vb_ = (const GAS char*)(kvbase + (size_t)(32 * (kt_) * dil) * QKV_COLS + 2 * DI); _Pragma("unroll") for (int jj = 0; jj < 8; ++jj) \
            vst[jj] = *(const GAS v4u*)(vb_ + (size_t)jj * (size_t)(4 * dil * QKV_COLS * 2) + voffV); } while (0)
        { const int kt0 = mbw > 4 ? mbw - 4 : 0; AT_LOADK(kt0); AT_LOADV(kt0); }
        for (int ii = 0; ii < 4; ++ii) {
            const int mb = mbw + ii;
            const size_t tq = (size_t)((32 * mb + ql) * dil + rres);
            { const GAS char* qb = (const GAS char*)(kvbase + (size_t)(32 * mb * dil) * QKV_COLS);
              bf16x8 qtmp[8];
#pragma unroll
              for (int ks = 0; ks < 8; ++ks) qtmp[ks] = *(const GAS bf16x8*)(qb + 32 * ks + voffK);
#pragma unroll
              for (int ks = 0; ks < 8; ++ks) *(LAS bf16x8*)(QT + (ql * 16 + ((2 * ks + hf) ^ (ql & 15))) * 16) = qtmp[ks]; }
            f32x16 o[4];
#pragma unroll
            for (int db = 0; db < 4; ++db)
#pragma unroll
                for (int r = 0; r < 16; ++r) o[db][r] = 0.f;
            float m = -1e30f, l = 0.f;
            for (int kt = (mb > 4 ? mb - 4 : 0); kt <= mb; ++kt) {
                const int delta = mb - kt;
                const int ktn = (kt < mb) ? kt + 1 : ((ii < 3) ? (mb > 3 ? mb - 3 : 0) : kt);
#pragma unroll
                for (int jj = 0; jj < 8; ++jj) { const int cid = lane + 64 * jj, row = cid >> 4, ch = cid & 15; *(LAS v4u*)(VT + row * AT_VROW + ch * 16) = vst[jj]; }
                __builtin_amdgcn_sched_barrier(0);
                AT_LOADV(ktn);
                f32x16 s;
                { const LAS float* rt = RT + (159 - (32 * delta + ql - 4 * hf));
#pragma unroll
                  for (int r = 0; r < 16; ++r) s[r] = rt[crow(r)]; }
#pragma unroll
                for (int ks = 0; ks < 8; ++ks) { const bf16x8 qfr = *(const LAS bf16x8*)(QT + (ql * 16 + ((2 * ks + hf) ^ (ql & 15))) * 16); s = __builtin_amdgcn_mfma_f32_32x32x16_bf16(kf[ks], qfr, s, 0, 0, 0); }
                __builtin_amdgcn_sched_barrier(0);
                AT_LOADK(ktn);
                __builtin_amdgcn_sched_barrier(0);
                float mx = s[0];
#pragma unroll
                for (int r = 1; r < 16; ++r) mx = fmaxf(mx, s[r]);
                mx = fmaxf(mx, __shfl_xor(mx, 32));
                const float mn = fmaxf(m, mx); const float alpha = __builtin_amdgcn_exp2f(m - mn); m = mn;
                float rs = 0.f;
#pragma unroll
                for (int r = 0; r < 16; ++r) { s[r] = __builtin_amdgcn_exp2f(s[r] - mn); rs += s[r]; }
                l = l * alpha + rs;
#pragma unroll
                for (int db = 0; db < 4; ++db)
#pragma unroll
                    for (int r = 0; r < 16; ++r) o[db][r] *= alpha;
                const bf16x8 pb0 = pack8(s[0], s[1], s[2], s[3], s[4], s[5], s[6], s[7]), pb1 = pack8(s[8], s[9], s[10], s[11], s[12], s[13], s[14], s[15]);
#pragma unroll
                for (int db = 0; db < 4; ++db) {
                    const s16x4 a0 = vtr(vtr_base + db * 64), a1 = vtr(vtr_base + 8 * AT_VROW + db * 64);
                    const s16x4 b0 = vtr(vtr_base + 16 * AT_VROW + db * 64), b1 = vtr(vtr_base + 24 * AT_VROW + db * 64);
                    const bf16x8 va0 = (bf16x8){a0[0], a0[1], a0[2], a0[3], a1[0], a1[1], a1[2], a1[3]}, va1 = (bf16x8){b0[0], b0[1], b0[2], b0[3], b1[0], b1[1], b1[2], b1[3]};
                    o[db] = __builtin_amdgcn_mfma_f32_32x32x16_bf16(va0, pb0, o[db], 0, 0, 0);
                    o[db] = __builtin_amdgcn_mfma_f32_32x32x16_bf16(va1, pb1, o[db], 0, 0, 0);
                }
            }
            l += __shfl_xor(l, 32);
            const float lse = (m + __builtin_amdgcn_logf(l)) * LN2;
            float wa = 0.f, wg = __builtin_amdgcn_rcpf(l), ln = lse;
            GAS float* lsp = lseacc + tq * 16 + h;
            if (g > 0) { const float la = *lsp; const float mm = fmaxf(la, lse); ln = mm + __logf(__expf(la - mm) + __expf(lse - mm)); wa = __expf(la - ln); wg = __expf(lse - ln) * wg; }
            GAS char* orow = (GAS char*)(oacc + (size_t)(32 * mb * dil + rres) * DI + h * 128);
#pragma unroll
            for (int db = 0; db < 4; ++db)
#pragma unroll
                for (int rq = 0; rq < 4; ++rq) { GAS u32x2v* p = (GAS u32x2v*)(orow + (32 * db + 8 * rq) * 2 + voffO); u32x2v a = (u32x2v){0u, 0u}; if (g > 0) a = *p;
                    u32x2v rr; rr.x = cvtpk(wa * blo(a.x) + wg * o[db][4 * rq + 0], wa * bhi(a.x) + wg * o[db][4 * rq + 1]); rr.y = cvtpk(wa * blo(a.y) + wg * o[db][4 * rq + 2], wa * bhi(a.y) + wg * o[db][4 * rq + 3]);
                    *p = rr; }
            if (hf == 0) *lsp = ln;
        }
#undef AT_LOADK
#undef AT_LOADV
    }
    __syncthreads();
}
#ifndef FAST_HG
#define FAST_HG 1
#endif
#ifndef FAST_ATT
#define FAST_ATT 1
#endif
__device__ __forceinline__ GAS void* ldp(LAS unsigned char* lds, int i) {
    const unsigned long long v = ((LAS unsigned long long*)(lds + TAB_OFF))[i];
    const unsigned lo = __builtin_amdgcn_readfirstlane((unsigned)v), hi = __builtin_amdgcn_readfirstlane((unsigned)(v >> 32));
    return (GAS void*)(((unsigned long long)hi << 32) | lo);
}
struct Args { const float* in[10]; float* out; unsigned char* ws; int lo, hi; };
__global__ void __launch_bounds__(NWAVES * 64, 2) fwd(Args args) {
    extern __shared__ __attribute__((aligned(16))) unsigned char lds_raw[];
    LAS unsigned char* lds = (LAS unsigned char*)lds_raw;
    cg::grid_group grid = cg::this_grid();
    const int tid0 = threadIdx.x;
    const int G = gridDim.x; const int bx = blockIdx.x;
    const int vcu = (G % 8 == 0) ? (bx % 8) * (G / 8) + bx / 8 : bx;
    const int NGW = G * NWAVES;
    { LAS unsigned long long* P = (LAS unsigned long long*)(lds + TAB_OFF);
      if (tid0 < 10) P[tid0] = (unsigned long long)args.in[tid0];
      if (tid0 == 10) P[10] = (unsigned long long)args.out;
      if (tid0 == 11) P[11] = (unsigned long long)args.ws;
      if (tid0 == 12) { ((LAS unsigned*)(lds + TAB_OFF + 256))[0] = 0u; ((LAS unsigned*)(lds + TAB_OFF + 256))[1] = 0u; }
      __syncthreads(); }
    (void)xcd_barrier_post((unsigned*)(args.ws + WS_CTL) + CW_BAR, (volatile LAS unsigned*)(lds + TAB_OFF + 256));
    const int ph_hi = args.hi;
    int ph = args.lo, rep = 0;
    while (ph < ph_hi) {
        int tid = threadIdx.x; asm volatile("" : "+v"(tid) :: "memory");
        const int lane = tid & 63, wave = __builtin_amdgcn_readfirstlane(tid >> 6), gw = vcu * NWAVES + wave;
        const GAS float* x = (const GAS float*)ldp(lds, 0); const GAS float* ln_g = (const GAS float*)ldp(lds, 1);
        GAS unsigned char* ws = (GAS unsigned char*)ldp(lds, 11); GAS float* Hres = (GAS float*)ldp(lds, 10); GAS bf16* U0 = (GAS bf16*)Hres;
        GAS bf16* Whgin = (GAS bf16*)(ws + WS_WHGIN); GAS bf16* Whgout = (GAS bf16*)(ws + WS_WHGOUT); GAS bf16* Wattin = (GAS bf16*)(ws + WS_WATTIN); GAS bf16* Wattout = (GAS bf16*)(ws + WS_WATTOUT);
        GAS bf16* QFIG = (GAS bf16*)(ws + WS_BIG0); GAS bf16* U1 = (GAS bf16*)(ws + WS_U1); GAS bf16* QKV = (GAS bf16*)(ws + WS_QKV); GAS bf16* YB = (GAS bf16*)(ws + WS_BIG1);
        if (ph == PH_PRO) {
            LAS float* scr = (LAS float*)(lds + wave * 16384);
            const GAS float* hg_w_in = (const GAS float*)ldp(lds, 2); const GAS float* hg_w_out = (const GAS float*)ldp(lds, 5); const GAS float* att_w_in = (const GAS float*)ldp(lds, 6); const GAS float* att_w_out = (const GAS float*)ldp(lds, 7);
            constexpr int I_A = (DM / 64) * (HG_COLS / 32), I_B = (DI / 64) * (DM / 32), I_C = (DM / 64) * (ATT_COLS / 32), I_D = I_B;
            for (int it = gw; it < I_A + I_B + I_C + I_D; it += NGW) {
                int r = it;
                if (r < I_A) { p0_transpose_item(hg_w_in, DM, HG_COLS, Whgin, scr, r, lane); continue; } r -= I_A;
                if (r < I_B) { p0_transpose_item(hg_w_out, DI, DM, Whgout, scr, r, lane); continue; } r -= I_B;
                if (r < I_C) { p0_transpose_item(att_w_in, DM, ATT_COLS, Wattin, scr, r, lane); continue; } r -= I_C;
                p0_transpose_item(att_w_out, DI, DM, Wattout, scr, r, lane);
            }
            for (int m = gw; m < T; m += NGW) rms_row_to_bf16(x + (size_t)m * DM, ln_g, U0 + (size_t)m * DM, lane);
        } else if (ph == PH_G1_0 || ph == PH_G1_1) {
            const int b = (ph == PH_G1_1);
            const pg8::Gemm g{U0 + (size_t)b * SEQ * DM, Whgin, SEQ, HG_COLS, DM}; const pg8::EpiBf16 E{QFIG, HG_COLS, 0, 1.0f};
            pg8::StaticOrder S; S.init(SEQ, HG_COLS, G, bx);
            pg8::gemm_phase<pg8::EpiBf16, pg8::StaticOrder, PG8_ALIGN, PG8_SP2>(lds, g, S, E);
        } else if (ph >= PH_G3_0 && ph < PH_GATE && ((ph - PH_G3_0) & 1) == 0) {
            const int k = (ph - PH_G3_0) >> 1, gi = k >> 1, b = k & 1;
            const pg8::Gemm g{U1 + (size_t)b * SEQ * DM, Wattin + (size_t)gi * QKV_COLS * DM, SEQ, QKV_COLS, DM}; const pg8::EpiBf16 E{QKV, QKV_COLS, FAST_ATT ? DI : 0, QSCALE};
            pg8::StaticOrder S; S.init(SEQ, QKV_COLS, G, bx);
            pg8::gemm_phase<pg8::EpiBf16, pg8::StaticOrder, PG8_ALIGN, PG8_SP2>(lds, g, S, E);
        } else if (ph == PH_G2 || ph == PH_G5) {
            pg8::Gemm g{YB, ph == PH_G2 ? Whgout : Wattout, T, DM, DI};
            pg8::EpiResF32 E{ph == PH_G2 ? x : Hres, Hres, DM};
            pg8::StaticOrder S; S.init(T, DM, G, bx);
            pg8::gemm_phase<pg8::EpiResF32, pg8::StaticOrder, PG8_ALIGN, PG8_SP2>(lds, g, S, E);
        } else if (ph == PH_GATE) {
            pg8::Gemm g{U1, Wattin + (size_t)3 * QKV_COLS * DM, T, DI, DM};
            pg8::EpiGateMul E{YB, DI};
            pg8::StaticOrder S; S.init(T, DI, G, bx);
            pg8::gemm_phase<pg8::EpiGateMul, pg8::StaticOrder, PG8_ALIGN, PG8_SP2>(lds, g, S, E);
        } else if (ph == PH_HGA_0 || ph == PH_HGA_1 || ph == PH_HGB_0 || ph == PH_HGB_1) {
            const int b = (ph >= PH_G1_1); const bool outp = (ph == PH_HGB_0 || ph == PH_HGB_1);
            const GAS float* lbl = (const GAS float*)ldp(lds, 3); const GAS float* ngp = (const GAS float*)ldp(lds, 4);
#if FAST_HG
            GAS float* Ust = (GAS float*)(ws + WS_HGU); GAS float* Ast = (GAS float*)(ws + WS_HGA);
            for (int item = vcu; item < 256; item += G) {
                if (outp) hgrn_pass<true>(lds, item, tid, QFIG, lbl, ngp, Ust, Ast, YB + (size_t)b * SEQ * DI);
                else hgrn_pass<false>(lds, item, tid, QFIG, lbl, ngp, Ust, Ast, YB + (size_t)b * SEQ * DI);
            }
#endif
        } else if (ph >= PH_G3_0 && ph < PH_GATE && ((ph - PH_G3_0) & 1) == 1) {
            const int k = (ph - PH_G3_0) >> 1, gi = k >> 1, b = k & 1;
#if FAST_ATT
            attn_phase(lds, vcu, G, tid, QKV, (const GAS float*)ldp(lds, 8), YB + (size_t)b * SEQ * DI, (GAS float*)(ws + WS_LSE) + (size_t)b * SEQ * 16, gi);
#endif
        } else if (ph == PH_NORM1) {
            for (int m = gw; m < T; m += NGW) rms_row_to_bf16(Hres + (size_t)m * DM, ln_g + DM, U1 + (size_t)m * DM, lane);
        } else if (ph == PH_FINAL) {
            for (int m = gw; m < T; m += NGW) rms_row_inplace_f32(Hres + (size_t)m * DM, (const GAS float*)ldp(lds, 9), lane);
        }
        if (((REPEAT_MASK >> ph) & 1u) && rep == 0) rep = 1; else { rep = 0; ++ph; }
        if (ph < ph_hi) {
            if (ph == 1 && rep == 0) grid.sync();
            else { XcdBarrier xb; xb.bar = (unsigned*)((GAS unsigned char*)ldp(lds, 11) + WS_CTL) + CW_BAR; xb.x = xb_xcc_id(); xb.st = (volatile LAS unsigned*)(lds + TAB_OFF + 256); xcd_barrier(xb); }
        }
    }
}

extern "C" void kernel_launch(void* const* d_in, const int* in_sizes, int n_in, void* d_out, int out_size, void* d_ws, size_t ws_size, hipStream_t stream) {
    static int grid = 0;
    if (grid == 0) {
        if (n_in != 10 || out_size != T * DM || ws_size < WS_END) { fprintf(stderr, "kernel_launch: unexpected shapes (n_in %d out %d ws %zu)\n", n_in, out_size, ws_size); grid = -1; return; }
        int dev = 0, cus = 0, per_cu = 0;
        hipGetDevice(&dev); hipDeviceGetAttribute(&cus, hipDeviceAttributeMultiprocessorCount, dev);
        if (hipFuncSetAttribute((const void*)fwd, hipFuncAttributeMaxDynamicSharedMemorySize, LDS_BYTES) != hipSuccess) { fprintf(stderr, "kernel_launch: hipFuncSetAttribute failed\n"); grid = -1; return; }
        hipOccupancyMaxActiveBlocksPerMultiprocessor(&per_cu, (const void*)fwd, NWAVES * 64, LDS_BYTES);
        if (per_cu < 1) { fprintf(stderr, "kernel_launch: occupancy query reports %d blocks per CU\n", per_cu); per_cu = 1; }
        (void)hipGetLastError();
        grid = cus * per_cu;
    }
    if (grid < 0) return;
    Args a{};
    for (int i = 0; i < 10; ++i) a.in[i] = (const float*)d_in[i];
    a.out = (float*)d_out; a.ws = (unsigned char*)d_ws;
    a.lo = PH_PRO; a.hi = PH_END;
    if (hipMemsetAsync((char*)d_ws + WS_CTL, 0, CTL_ZERO_BYTES, stream) != hipSuccess) { fprintf(stderr, "kernel_launch: hipMemsetAsync failed\n"); return; }
    void* kargs[] = {&a};
    const hipError_t le = hipLaunchCooperativeKernel((const void*)fwd, dim3(grid), dim3(NWAVES * 64), kargs, LDS_BYTES, stream);
    if (le != hipSuccess) fprintf(stderr, "kernel_launch: cooperative launch failed: %s (grid %d)\n", hipGetErrorString(le), grid);
}
```

```cpp
#include <hip/hip_runtime.h>
#include <hip/hip_cooperative_groups.h>
#include <cstdio>
#include <cstdint>
namespace cg = cooperative_groups;
namespace pg8 {
#define PG8_LAS __attribute__((address_space(3)))
typedef unsigned short bf16_t;
typedef short bf16x8 __attribute__((ext_vector_type(8)));
typedef float f32x4 __attribute__((ext_vector_type(4)));
typedef unsigned u32x4 __attribute__((ext_vector_type(4)));
constexpr int BM = 256, BK = 64, HALF = 128, HTB = HALF * BK * 2  , STAGE_BYTES = 8 * HTB, NXCD = 8, WGM = 8;

__host__ __device__ __forceinline__ int lds_byte(int r, int c) { const int st = (r >> 4) * 2 + (c >> 5), rr = r & 15, cc = c & 31, ob = rr * 64 + cc * 2; return st * 1024 + (ob ^ (((ob >> 9) & 1) << 5)); }
__host__ __device__ __forceinline__ void stage_rc(int b, int& R, int& C) { const int st = b / 1024, sb = b % 1024, swz = sb ^ (((sb >> 9) & 1) << 5); R = (st >> 1) * 16 + swz / 64; C = (st & 1) * 32 + (swz % 64) / 2; }
__host__ __device__ __forceinline__ int perm32(int rho) { const int n = rho >> 4, i = rho & 15; return 8 * (i >> 2) + 4 * n + (i & 3); }

struct Unit { int pm, pn; };
#define PG8_GAS __attribute__((address_space(1)))
struct Gemm { const PG8_GAS bf16_t* A; const PG8_GAS bf16_t* Bt; int M, N, K; };

struct StaticOrder {
    int nM, nN, nwg, G, c;
    __host__ __device__ void init(int M, int N, int G_, int c_) { nM = M / BM; nN = N / BM; nwg = nM * nN; G = G_; c = c_; }
    __host__ __device__ bool next(int i, Unit& u) const {
        const long L = (long)i * G + c; if (L >= nwg) return false;
        int wgid = (int)L; { const int q = nwg / NXCD, r = nwg % NXCD, xcd = wgid % NXCD, off = wgid / NXCD; wgid = (xcd < r ? xcd * (q + 1) : r * (q + 1) + (xcd - r) * q) + off; }
        const int nig = WGM * nN, gid = wgid / nig, fm = gid * WGM, gsz = (nM - fm) < WGM ? (nM - fm) : WGM;
        u.pm = fm + ((wgid % nig) % gsz); u.pn = (wgid % nig) / gsz; return true;
    }
    __device__ __forceinline__ void a_ready(const Unit&) const {}
    __device__ __forceinline__ void done(const Unit&) const {}
};

__device__ __forceinline__ unsigned cvt_pk_bf16(float lo, float hi) { unsigned r; asm volatile("v_cvt_pk_bf16_f32 %0, %1, %2" : "=v"(r) : "v"(lo), "v"(hi)); return r; }
typedef float f32x2 __attribute__((ext_vector_type(2)));
__device__ __forceinline__ float bf_lo(unsigned w) { return __uint_as_float(w << 16); }
__device__ __forceinline__ float bf_hi(unsigned w) { return __uint_as_float(w & 0xffff0000u); }
struct EpiBf16 {
    static constexpr bool PERM = true, AFTER_DRAIN = false;
    PG8_GAS bf16_t* O; int ldc; int qcols; float qscale; int hmajor; int ldil; int seq;
    __device__ __forceinline__ void operator()(const f32x4 (&acc)[2][2][4][2], const Unit& u, int wr, int wc, int fr, int fq) const {
        const int row0 = u.pm * BM + wr * 64 + fr, col0 = u.pn * BM + wc * 32 + 8 * fq;
        const float sc = (u.pn * BM < qcols) ? qscale : 1.0f;
        PG8_GAS bf16_t* Ob = O; int cb = col0;
        if (hmajor > 0) { Ob = O + (size_t)(u.pn >> 1) * ((size_t)hmajor * 512); cb = (u.pn & 1) * BM + wc * 32 + 8 * fq; }
        if (hmajor < 0) {
            const int nrow = -hmajor, Lr = seq >> ldil, dm = (1 << ldil) - 1; const int bb = (u.pm * BM) / seq, boff = bb * seq;
#pragma unroll
            for (int ai = 0; ai < 2; ++ai)
#pragma unroll
                for (int m = 0; m < 4; ++m) { const int t = row0 + ai * HALF + m * 16 - boff; const size_t ri = (size_t)boff + (size_t)(t & dm) * Lr + (t >> ldil);
#pragma unroll
                    for (int bj = 0; bj < 2; ++bj) { const f32x4 v0 = acc[ai][bj][m][0] * sc, v1 = acc[ai][bj][m][1] * sc;
                        u32x4 w; w.x = cvt_pk_bf16(v0[0], v0[1]); w.y = cvt_pk_bf16(v0[2], v0[3]); w.z = cvt_pk_bf16(v1[0], v1[1]); w.w = cvt_pk_bf16(v1[2], v1[3]);
                        *(PG8_GAS u32x4*)(O + (((size_t)((u.pn >> 3) * 16 + 2 * (u.pn & 7) + bj) * nrow + ri) * 128 + wc * 32 + 8 * fq)) = w; } }
            return; }
#pragma unroll
        for (int ai = 0; ai < 2; ++ai)
#pragma unroll
            for (int m = 0; m < 4; ++m) { PG8_GAS bf16_t* rowp = Ob + (size_t)(row0 + ai * HALF + m * 16) * ldc + cb;
#pragma unroll
                for (int bj = 0; bj < 2; ++bj) { const f32x4 v0 = acc[ai][bj][m][0] * sc, v1 = acc[ai][bj][m][1] * sc;
                    u32x4 w; w.x = cvt_pk_bf16(v0[0], v0[1]); w.y = cvt_pk_bf16(v0[2], v0[3]); w.z = cvt_pk_bf16(v1[0], v1[1]); w.w = cvt_pk_bf16(v1[2], v1[3]);
                    *(PG8_GAS u32x4*)(rowp + bj * HALF) = w; } }
    }
};
struct EpiBf16Split {
    static constexpr bool PERM = true, AFTER_DRAIN = false;
    PG8_GAS bf16_t* O; PG8_GAS bf16_t* O2; int ldc; int split;
    __device__ __forceinline__ void operator()(const f32x4 (&acc)[2][2][4][2], const Unit& u, int wr, int wc, int fr, int fq) const {
        const int row0 = u.pm * BM + wr * 64 + fr, col0 = u.pn * BM + wc * 32 + 8 * fq;
        PG8_GAS bf16_t* Ob = (u.pm * BM < split) ? O : O2 - (size_t)split * ldc;
#pragma unroll
        for (int ai = 0; ai < 2; ++ai)
#pragma unroll
            for (int m = 0; m < 4; ++m) { PG8_GAS bf16_t* rowp = Ob + (size_t)(row0 + ai * HALF + m * 16) * ldc + col0;
#pragma unroll
                for (int bj = 0; bj < 2; ++bj) { const f32x4 v0 = acc[ai][bj][m][0], v1 = acc[ai][bj][m][1];
                    u32x4 w; w.x = cvt_pk_bf16(v0[0], v0[1]); w.y = cvt_pk_bf16(v0[2], v0[3]); w.z = cvt_pk_bf16(v1[0], v1[1]); w.w = cvt_pk_bf16(v1[2], v1[3]);
                    *(PG8_GAS u32x4*)(rowp + bj * HALF) = w; } }
    }
};
struct EpiResF32 {
    static constexpr bool PERM = false, AFTER_DRAIN = false;
    const PG8_GAS float* base; PG8_GAS float* out; int ldc;
    __device__ __forceinline__ void operator()(const f32x4 (&acc)[2][2][4][2], const Unit& u, int wr, int wc, int fr, int fq) const {
        const int row0 = u.pm * BM + wr * 64 + fr, col0 = u.pn * BM + wc * 32 + 4 * fq;
#pragma unroll
        for (int ai = 0; ai < 2; ++ai)
#pragma unroll
            for (int m = 0; m < 4; ++m) { const size_t off = (size_t)(row0 + ai * HALF + m * 16) * ldc + col0;
#pragma unroll
                for (int bj = 0; bj < 2; ++bj)
#pragma unroll
                    for (int n = 0; n < 2; ++n) { const f32x4 b = *(const PG8_GAS f32x4*)(base + off + bj * HALF + n * 16); *(PG8_GAS f32x4*)(out + off + bj * HALF + n * 16) = b + acc[ai][bj][m][n]; } }
    }
};
struct EpiGateMul {
    static constexpr bool PERM = true, AFTER_DRAIN = false;
    const PG8_GAS bf16_t* OH; PG8_GAS bf16_t* Y; int ldc; int seq;
    __device__ __forceinline__ f32x2 sg2(f32x2 o, f32x2 g) const { const f32x2 t = g * (-1.4426950408889634f); f32x2 e; e.x = __builtin_amdgcn_exp2f(t.x); e.y = __builtin_amdgcn_exp2f(t.y);
        const f32x2 d = e + 1.0f; f32x2 r; r.x = __builtin_amdgcn_rcpf(d.x); r.y = __builtin_amdgcn_rcpf(d.y); return (o * g) * r; }
    __device__ __forceinline__ void operator()(const f32x4 (&acc)[2][2][4][2], const Unit& u, int wr, int wc, int fr, int fq) const {
        const int row0 = u.pm * BM + wr * 64 + fr, col0 = u.pn * BM + wc * 32 + 8 * fq;
        const int b = (u.pm * BM) / seq;
        const PG8_GAS bf16_t* ob = OH + ((size_t)(b * 16 + 2 * u.pn) * seq + (size_t)(row0 - b * seq)) * 128 + wc * 32 + 8 * fq;
        u32x4 ov[2][4][2];
#pragma unroll
        for (int ai = 0; ai < 2; ++ai)
#pragma unroll
            for (int m = 0; m < 4; ++m)
#pragma unroll
                for (int bj = 0; bj < 2; ++bj) ov[ai][m][bj] = *(const PG8_GAS u32x4*)(ob + ((size_t)bj * seq + (size_t)(ai * HALF + m * 16)) * 128);
#pragma unroll
        for (int ai = 0; ai < 2; ++ai)
#pragma unroll
            for (int m = 0; m < 4; ++m) { PG8_GAS bf16_t* rowp = Y + (size_t)(row0 + ai * HALF + m * 16) * ldc + col0;
#pragma unroll
                for (int bj = 0; bj < 2; ++bj) { const f32x4 v0 = acc[ai][bj][m][0], v1 = acc[ai][bj][m][1]; const u32x4 o4 = ov[ai][m][bj];
                    const f32x2 a = sg2((f32x2){bf_lo(o4.x), bf_hi(o4.x)}, (f32x2){v0[0], v0[1]}), bq = sg2((f32x2){bf_lo(o4.y), bf_hi(o4.y)}, (f32x2){v0[2], v0[3]});
                    const f32x2 c = sg2((f32x2){bf_lo(o4.z), bf_hi(o4.z)}, (f32x2){v1[0], v1[1]}), d = sg2((f32x2){bf_lo(o4.w), bf_hi(o4.w)}, (f32x2){v1[2], v1[3]});
                    u32x4 w; w.x = cvt_pk_bf16(a.x, a.y); w.y = cvt_pk_bf16(bq.x, bq.y); w.z = cvt_pk_bf16(c.x, c.y); w.w = cvt_pk_bf16(d.x, d.y);
                    *(PG8_GAS u32x4*)(rowp + bj * HALF) = w; } }
    }
};
template <class Epi, class Sched, bool ALIGN_EPI = false, bool SP2 = false>
__device__ __forceinline__ void gemm_phase(PG8_LAS unsigned char* lds, const Gemm g, const Sched& S, const Epi& E) {
    int tid_ = threadIdx.x; asm volatile("" : "+v"(tid_));
    const int tid = tid_, wid = __builtin_amdgcn_readfirstlane(tid >> 6), lane = tid & 63, wr = wid >> 2, wc = wid & 3, fr = lane & 15, fq = lane >> 4;
    const int K = g.K, nt = K / BK;
    unsigned voffA[2], voffB[2];
#pragma unroll
    for (int i = 0; i < 2; ++i) { int R, C; stage_rc(tid * 16 + i * 8192, R, C); const int Rb = Epi::PERM ? ((R & ~31) + perm32(R & 31)) : R;
        voffA[i] = (unsigned)(R * K + C) * 2u; voffB[i] = (unsigned)(Rb * K + C) * 2u; }
    const size_t kstep = (size_t)(BK * 2);
    const size_t hstep = (size_t)HALF * K * 2;
    const size_t tstep = 2 * hstep;
    const unsigned ldsw = (unsigned)wid * 1024u;
    const int aoff = lds_byte(wr * 64 + fr, fq * 8), boff = lds_byte(wc * 32 + fr, fq * 8);
#define PG8_SA(b, h) (((b) * 2 + (h)) * HTB)
#define PG8_SB(b, h) ((4 + (b) * 2 + (h)) * HTB)
#define PG8_STAGE(bufoff, gbase, voff) do { _Pragma("unroll") for (int _i = 0; _i < 2; ++_i) \
        __builtin_amdgcn_global_load_lds((const PG8_GAS unsigned*)((const PG8_GAS char*)(gbase) + (voff)[_i]), (PG8_LAS unsigned*)(lds + (bufoff) + ldsw + _i * 8192), 16, 0, 0); } while (0)
#define PG8_LDA(dst, b, h) do { _Pragma("unroll") for (int m = 0; m < 4; ++m) _Pragma("unroll") for (int k = 0; k < 2; ++k) dst[m][k] = *(const PG8_LAS bf16x8*)(lds + PG8_SA(b, h) + aoff + m * 2048 + k * 1024); } while (0)
#define PG8_LDB(dst, b, h) do { _Pragma("unroll") for (int n = 0; n < 2; ++n) _Pragma("unroll") for (int k = 0; k < 2; ++k) dst[n][k] = *(const PG8_LAS bf16x8*)(lds + PG8_SB(b, h) + boff + n * 2048 + k * 1024); } while (0)
#define PG8_MMA(ai, bj, At, Bt) do { __builtin_amdgcn_s_setprio(1); _Pragma("unroll") for (int m = 0; m < 4; ++m) _Pragma("unroll") for (int n = 0; n < 2; ++n) _Pragma("unroll") for (int k = 0; k < 2; ++k) \
        acc[ai][bj][m][n] = __builtin_amdgcn_mfma_f32_16x16x32_bf16(Bt[n][k], At[m][k], acc[ai][bj][m][n], 0, 0, 0); __builtin_amdgcn_s_setprio(0); } while (0)
#define PG8_WAIT_V(n) asm volatile("s_waitcnt vmcnt(" #n ")" ::: "memory")
#define PG8_WAIT_L(n) asm volatile("s_waitcnt lgkmcnt(" #n ")" ::: "memory")
#define PG8_BAR __builtin_amdgcn_s_barrier()
#define PG8_SCHED __builtin_amdgcn_sched_barrier(0)
    Unit cur, nxt; int ui = 0;
    if (!S.next(0, cur)) return;
    f32x4 acc[2][2][4][2];
#pragma unroll
    for (int a = 0; a < 2; ++a)
#pragma unroll
        for (int b = 0; b < 2; ++b)
#pragma unroll
            for (int m = 0; m < 4; ++m)
#pragma unroll
                for (int n = 0; n < 2; ++n) acc[a][b][m][n] = (f32x4){0.f, 0.f, 0.f, 0.f};
    bf16x8 At[4][2], B0[2][2], B1[2][2];
    const PG8_GAS char* cA = (const PG8_GAS char*)g.A + (size_t)cur.pm * tstep; const PG8_GAS char* cB = (const PG8_GAS char*)g.Bt + (size_t)cur.pn * tstep;
    S.a_ready(cur);
    if constexpr (SP2) {
        PG8_STAGE(PG8_SB(0, 0), cB, voffB); PG8_STAGE(PG8_SB(0, 1), cB + hstep, voffB); PG8_STAGE(PG8_SA(0, 0), cA, voffA); PG8_STAGE(PG8_SA(0, 1), cA + hstep, voffA);
        if (wr == 1) PG8_BAR;
        PG8_WAIT_V(2); PG8_BAR;
        PG8_STAGE(PG8_SB(1, 0), cB + kstep, voffB); PG8_STAGE(PG8_SA(1, 0), cA + kstep, voffA); PG8_STAGE(PG8_SB(1, 1), cB + hstep + kstep, voffB);
        PG8_WAIT_V(6); PG8_BAR;
    } else {
        PG8_STAGE(PG8_SB(0, 0), cB, voffB); PG8_STAGE(PG8_SA(0, 0), cA, voffA); PG8_STAGE(PG8_SB(0, 1), cB + hstep, voffB); PG8_STAGE(PG8_SA(0, 1), cA + hstep, voffA);
        if (wr == 1) PG8_BAR;
        PG8_WAIT_V(4); PG8_BAR;
        PG8_STAGE(PG8_SB(1, 0), cB + kstep, voffB); PG8_STAGE(PG8_SA(1, 0), cA + kstep, voffA); PG8_STAGE(PG8_SB(1, 1), cB + hstep + kstep, voffB);
        PG8_WAIT_V(6); PG8_BAR;
    }
    for (;;) {
        const bool has_next = S.next(ui + 1, nxt);
        const PG8_GAS char* nA = has_next ? (const PG8_GAS char*)g.A + (size_t)nxt.pm * tstep : cA; const PG8_GAS char* nB = has_next ? (const PG8_GAS char*)g.Bt + (size_t)nxt.pn * tstep : cB;
        for (int t = 0; t < nt; t += 2) {
            const bool last = (t == nt - 2);
            const PG8_GAS char* a1 = cA + (size_t)(t + 1) * kstep;
            const PG8_GAS char* a2 = last ? nA : cA + (size_t)(t + 2) * kstep; const PG8_GAS char* b2 = last ? nB : cB + (size_t)(t + 2) * kstep;
            const PG8_GAS char* a3 = a2 + kstep; const PG8_GAS char* b3 = b2 + kstep;
            if (last && has_next) S.a_ready(nxt);
            if constexpr (SP2) {
            PG8_LDB(B0, 0, 0); PG8_LDB(B1, 0, 1); PG8_SCHED; PG8_LDA(At, 0, 0); PG8_STAGE(PG8_SA(1, 1), a1 + hstep, voffA);
            PG8_WAIT_V(8); PG8_WAIT_L(0); PG8_BAR; PG8_MMA(0, 0, At, B0); PG8_MMA(0, 1, At, B1); PG8_BAR; PG8_SCHED;
            PG8_LDA(At, 0, 1); PG8_STAGE(PG8_SB(0, 0), b2, voffB); PG8_STAGE(PG8_SB(0, 1), b2 + hstep, voffB); PG8_STAGE(PG8_SA(0, 0), a2, voffA);
            PG8_WAIT_V(8); PG8_WAIT_L(0); PG8_BAR; PG8_MMA(1, 0, At, B0); PG8_MMA(1, 1, At, B1); PG8_BAR; PG8_SCHED;
            PG8_LDB(B0, 1, 0); PG8_LDB(B1, 1, 1); PG8_SCHED; PG8_LDA(At, 1, 0); PG8_STAGE(PG8_SA(0, 1), a2 + hstep, voffA);
            PG8_WAIT_V(8); PG8_WAIT_L(0); PG8_BAR; PG8_MMA(0, 0, At, B0); PG8_MMA(0, 1, At, B1); PG8_BAR; PG8_SCHED;
            PG8_LDA(At, 1, 1); PG8_STAGE(PG8_SB(1, 0), b3, voffB); PG8_STAGE(PG8_SB(1, 1), b3 + hstep, voffB); PG8_STAGE(PG8_SA(1, 0), a3, voffA);
            PG8_WAIT_V(8); PG8_WAIT_L(0); PG8_BAR; PG8_MMA(1, 0, At, B0); PG8_MMA(1, 1, At, B1); PG8_BAR; PG8_SCHED;
            } else {
            PG8_LDB(B0, 0, 0); PG8_SCHED; PG8_LDA(At, 0, 0); PG8_STAGE(PG8_SA(1, 1), a1 + hstep, voffA);
            PG8_WAIT_L(8); PG8_BAR; PG8_WAIT_L(0); PG8_MMA(0, 0, At, B0); PG8_BAR; PG8_SCHED;
            PG8_LDB(B1, 0, 1); PG8_STAGE(PG8_SB(0, 0), b2, voffB);
            PG8_BAR; PG8_WAIT_L(0); PG8_MMA(0, 1, At, B1); PG8_BAR;
            PG8_LDA(At, 0, 1); PG8_STAGE(PG8_SA(0, 0), a2, voffA);
            PG8_BAR; PG8_WAIT_L(0); PG8_MMA(1, 0, At, B0); PG8_BAR; PG8_SCHED;
            PG8_STAGE(PG8_SB(0, 1), b2 + hstep, voffB);
            PG8_WAIT_V(6); PG8_BAR; PG8_MMA(1, 1, At, B1); PG8_BAR;
            PG8_LDB(B0, 1, 0); PG8_SCHED; PG8_LDA(At, 1, 0); PG8_STAGE(PG8_SA(0, 1), a2 + hstep, voffA);
            PG8_WAIT_L(8); PG8_BAR; PG8_WAIT_L(0); PG8_MMA(0, 0, At, B0); PG8_BAR; PG8_SCHED;
            PG8_LDB(B1, 1, 1); PG8_STAGE(PG8_SB(1, 0), b3, voffB);
            PG8_BAR; PG8_WAIT_L(0); PG8_MMA(0, 1, At, B1); PG8_BAR;
            PG8_LDA(At, 1, 1); PG8_STAGE(PG8_SA(1, 0), a3, voffA);
            PG8_BAR; PG8_WAIT_L(0); PG8_MMA(1, 0, At, B0); PG8_BAR; PG8_SCHED;
            PG8_STAGE(PG8_SB(1, 1), b3 + hstep, voffB);
            PG8_WAIT_V(6); PG8_BAR; PG8_MMA(1, 1, At, B1); PG8_BAR;
            }
        }
        if constexpr (ALIGN_EPI) { if (wr == 0) PG8_BAR; }
        if constexpr (!Epi::AFTER_DRAIN) { E(acc, cur, wr, wc, fr, fq); S.done(cur); }
        if (!has_next) break;
#pragma unroll
        for (int a = 0; a < 2; ++a)
#pragma unroll
            for (int b = 0; b < 2; ++b)
#pragma unroll
                for (int m = 0; m < 4; ++m)
#pragma unroll
                    for (int n = 0; n < 2; ++n) acc[a][b][m][n] = (f32x4){0.f, 0.f, 0.f, 0.f};
        cur = nxt; cA = nA; cB = nB; ++ui;
        if constexpr (ALIGN_EPI) { if (wr == 1) PG8_BAR; }
    }
    PG8_WAIT_V(0);
    if constexpr (!ALIGN_EPI) { if (wr == 0) PG8_BAR; }
    PG8_BAR;
    if constexpr (Epi::AFTER_DRAIN) { E.fused(acc, cur, wr, wc, fr, fq, lds, wid, lane); S.done(cur); }
#undef PG8_SA
#undef PG8_SB
#undef PG8_STAGE
#undef PG8_LDA
#undef PG8_LDB
#undef PG8_MMA
#undef PG8_WAIT_V
#undef PG8_WAIT_L
#undef PG8_BAR
#undef PG8_SCHED
}
}
#ifndef PG8_SP2
#define PG8_SP2 true
#endif
#ifndef PG8_ALIGN
#define PG8_ALIGN true
#endif
constexpr int NWAVES = 8;
constexpr int BATCH = 2, SEQ = 16384, DM = 1024, DI = 2048, T = BATCH * SEQ;
constexpr int HG_COLS = 4 * DI;
constexpr int ATT_COLS = 10 * DI;
constexpr int QKV_COLS = 3 * DI;
constexpr float EPS = 1e-6f;
constexpr size_t MiB = 1u << 20;
constexpr size_t WS_CTL = 0;
constexpr size_t WS_WATTIN = 1 * MiB, WS_WATTOUT = 41 * MiB, WS_WHGOUT = 45 * MiB, WS_WHGIN = 49 * MiB;
constexpr size_t WS_LSE = 109 * MiB;
constexpr size_t WS_RS = 111 * MiB;
constexpr size_t WS_Y1 = 112 * MiB;
constexpr size_t WS_Y2 = 112 * MiB, WS_Y2P = 240 * MiB;
constexpr size_t WS_BIG0 = 96 * MiB;
constexpr size_t WS_U1 = 45 * MiB, WS_QKV = 112 * MiB;
constexpr size_t WS_BIG1 = 352 * MiB;
constexpr size_t WS_END = 512 * MiB;
constexpr int RING_BYTES = 131072;
constexpr int LDS_BYTES = 155648;
constexpr int TAB_OFF = 153600;
enum { PH_PRO = 0, PH_G1_0 = 1, PH_HGA_0 = 2, PH_HGB_0 = 3, PH_G1_1 = 4, PH_HGA_1 = 5, PH_HGB_1 = 6, PH_G2 = 7, PH_NORM1 = 8, PH_G3_0 = 9  , PH_GATE = 15, PH_G5 = 16, PH_FINAL = 17, PH_END = 18 };

#define LAS __attribute__((address_space(3)))
#define GAS __attribute__((address_space(1)))
typedef unsigned short bf16;
typedef unsigned v4u __attribute__((ext_vector_type(4)));
typedef float f32x4 __attribute__((ext_vector_type(4)));
typedef short s16x4t __attribute__((ext_vector_type(4)));
typedef short v4i16t __attribute__((ext_vector_type(4)));
#define LDS_WAIT() asm volatile("s_waitcnt lgkmcnt(0)" ::: "memory")
__device__ __forceinline__ unsigned f2bf(float f) { unsigned u = __builtin_bit_cast(unsigned, f); return (u + 0x7fffu + ((u >> 16) & 1u)) >> 16; }
__device__ __forceinline__ unsigned pk2(float lo, float hi) { return f2bf(lo) | (f2bf(hi) << 16); }
__device__ __forceinline__ float bf2f(unsigned short b) { return __uint_as_float(((unsigned)b) << 16); }
__device__ __forceinline__ float blo(unsigned w) { return __uint_as_float(w << 16); }
__device__ __forceinline__ float bhi(unsigned w) { return __uint_as_float(w & 0xffff0000u); }
__device__ __forceinline__ float wave_sum(float v) {
#pragma unroll
    for (int o = 1; o < 64; o <<= 1) v += __shfl_xor(v, o);
    return v;
}
__device__ const unsigned char BUCKET[3][129] = {
{0,1,2,3,4,5,6,7,8,9,10,11,12,13,14,15,16,16,16,16,16,16,17,17,17,17,17,17,17,17,18,18,18,18,18,18,18,18,18,18,19,19,19,19,19,19,19,19,19,19,19,19,19,19,20,20,20,20,20,20,20,20,20,20,20,20,20,20,20,20,20,20,20,21,21,21,21,21,21,21,21,21,21,21,21,21,21,21,21,21,21,21,21,21,21,21,21,21,21,22,22,22,22,22,22,22,22,22,22,22,22,22,22,22,22,22,22,22,22,22,22,22,22,22,22,22,22,22,22},
{0,4,8,12,16,16,17,17,18,18,19,19,19,19,20,20,20,20,20,21,21,21,21,21,21,22,22,22,22,22,22,22,22,22,23,23,23,23,23,23,23,23,23,23,23,23,24,24,24,24,24,24,24,24,24,24,24,24,24,24,24,24,25,25,25,25,25,25,25,25,25,25,25,25,25,25,25,25,25,25,25,25,25,26,26,26,26,26,26,26,26,26,26,26,26,26,26,26,26,26,26,26,26,26,26,26,26,26,26,26,26,26,26,27,27,27,27,27,27,27,27,27,27,27,27,27,27,27,27},
{0,16,18,19,20,21,21,22,22,23,23,23,24,24,24,24,25,25,25,25,25,26,26,26,26,26,26,26,26,27,27,27,27,27,27,27,27,27,27,28,28,28,28,28,28,28,28,28,28,28,28,28,29,29,29,29,29,29,29,29,29,29,29,29,29,29,29,29,29,29,30,30,30,30,30,30,30,30,30,30,30,30,30,30,30,30,30,30,30,30,30,30,30,30,30,31,31,31,31,31,31,31,31,31,31,31,31,31,31,31,31,31,31,31,31,31,31,31,31,31,31,31,31,31,31,31,31,31,31}};

__device__ __forceinline__ void p0_transpose_item(const GAS float* W, int K, int N, GAS bf16* WT, LAS unsigned char* scr, int item, int lane, bool hperm = false) {
    const int nblk = N / 64, kb = item / nblk, nb = item % nblk, k0 = 64 * kb, n0 = 64 * nb;
    const GAS float* src = W + (size_t)(k0 + (lane >> 4)) * N + n0 + 4 * (lane & 15);
    f32x4 v[16];
#pragma unroll
    for (int i = 0; i < 16; ++i) v[i] = *(const GAS f32x4*)(src + (size_t)(4 * i) * N);
#pragma unroll
    for (int i = 0; i < 16; ++i) *(LAS unsigned long long*)(scr + (4 * i + (lane >> 4)) * 160 + (lane & 15) * 8) = (unsigned long long)pk2(v[i].x, v[i].y) | ((unsigned long long)pk2(v[i].z, v[i].w) << 32);
    LDS_WAIT(); asm volatile("" ::: "memory");
    const LAS unsigned char* tb = scr + ((lane & 15) >> 2) * 160 + (16 * (lane >> 4) + 4 * (lane & 3)) * 2;
    v4u o[8];
#pragma unroll
    for (int j = 0; j < 8; ++j) { const s16x4t a = __builtin_bit_cast(s16x4t, __builtin_amdgcn_ds_read_tr16_b64_v4i16((LAS v4i16t*)(tb + (8 * j) * 160)));
        const s16x4t b = __builtin_bit_cast(s16x4t, __builtin_amdgcn_ds_read_tr16_b64_v4i16((LAS v4i16t*)(tb + (8 * j + 4) * 160)));
        o[j].x = (unsigned)(unsigned short)a[0] | ((unsigned)(unsigned short)a[1] << 16); o[j].y = (unsigned)(unsigned short)a[2] | ((unsigned)(unsigned short)a[3] << 16);
        o[j].z = (unsigned)(unsigned short)b[0] | ((unsigned)(unsigned short)b[1] << 16); o[j].w = (unsigned)(unsigned short)b[2] | ((unsigned)(unsigned short)b[3] << 16); }
    int nr = n0 + lane; if (hperm) nr = ((nr >> 7) & 15) * 512 + (nr >> 11) * 128 + (nr & 127);
    GAS v4u* dst = (GAS v4u*)(WT + (size_t)nr * K + k0);
#pragma unroll
    for (int j = 0; j < 8; ++j) dst[j] = o[j];
    LDS_WAIT(); asm volatile("" ::: "memory");
}
constexpr int NR = 4;
__device__ __forceinline__ void rms_rows_to_bf16(const GAS float* x, int m, int step, int mend, const f32x4 (&gv)[4], GAS bf16* o, int lane) {
    f32x4 v[NR][4]; int mr[NR];
#pragma unroll
    for (int r = 0; r < NR; ++r) { mr[r] = (m + r * step < mend) ? m + r * step : m; const GAS f32x4* xr = (const GAS f32x4*)(x + (size_t)mr[r] * DM) + lane;
#pragma unroll
        for (int j = 0; j < 4; ++j) v[r][j] = xr[64 * j]; }
#pragma unroll
    for (int r = 0; r < NR; ++r) { float s = 0.f;
#pragma unroll
        for (int j = 0; j < 4; ++j) s += (v[r][j].x * v[r][j].x + v[r][j].y * v[r][j].y) + (v[r][j].z * v[r][j].z + v[r][j].w * v[r][j].w);
        const float rs = 1.0f / sqrtf(wave_sum(s) * (1.0f / DM) + EPS);
        GAS unsigned long long* o8 = (GAS unsigned long long*)(o + (size_t)mr[r] * DM) + lane;
#pragma unroll
        for (int j = 0; j < 4; ++j) { const f32x4 ov = v[r][j] * rs * gv[j]; o8[64 * j] = (unsigned long long)pk2(ov.x, ov.y) | ((unsigned long long)pk2(ov.z, ov.w) << 32); } }
}
__device__ __forceinline__ void rms_rows_xy_to_bf16(const GAS float* x, const GAS bf16* y, int m, int step, int mend, const f32x4 (&gv)[4], GAS bf16* o, GAS float* rsout, int lane) {
    f32x4 v[NR][4]; unsigned long long yy[NR][4]; int mr[NR];
#pragma unroll
    for (int r = 0; r < NR; ++r) { mr[r] = (m + r * step < mend) ? m + r * step : m; const GAS f32x4* xr = (const GAS f32x4*)(x + (size_t)mr[r] * DM) + lane; const GAS unsigned long long* yr = (const GAS unsigned long long*)(y + (size_t)mr[r] * DM) + lane;
#pragma unroll
        for (int j = 0; j < 4; ++j) { v[r][j] = xr[64 * j]; yy[r][j] = yr[64 * j]; } }
#pragma unroll
    for (int r = 0; r < NR; ++r) { float s = 0.f;
#pragma unroll
        for (int j = 0; j < 4; ++j) { const unsigned lo = (unsigned)yy[r][j], hi = (unsigned)(yy[r][j] >> 32);
            v[r][j] = v[r][j] + (f32x4){blo(lo), bhi(lo), blo(hi), bhi(hi)}; s += (v[r][j].x * v[r][j].x + v[r][j].y * v[r][j].y) + (v[r][j].z * v[r][j].z + v[r][j].w * v[r][j].w); }
        const float rs = 1.0f / sqrtf(wave_sum(s) * (1.0f / DM) + EPS);
        if (lane == 0) rsout[mr[r]] = rs;
        GAS unsigned long long* o8 = (GAS unsigned long long*)(o + (size_t)mr[r] * DM) + lane;
#pragma unroll
        for (int j = 0; j < 4; ++j) { const f32x4 ov = v[r][j] * rs * gv[j]; o8[64 * j] = (unsigned long long)pk2(ov.x, ov.y) | ((unsigned long long)pk2(ov.z, ov.w) << 32); } }
}
__device__ __forceinline__ void rms_rows_final(const GAS bf16* u1, const GAS float* rsin, const GAS bf16* y2, int m, int step, int mend, const f32x4 (&ig1)[4], const f32x4 (&gf)[4], GAS float* out, int lane) {
    unsigned long long uu[NR][4], yy[NR][4]; float rsv[NR]; int mr[NR];
#pragma unroll
    for (int r = 0; r < NR; ++r) { mr[r] = (m + r * step < mend) ? m + r * step : m; const GAS unsigned long long* ur = (const GAS unsigned long long*)(u1 + (size_t)mr[r] * DM) + lane; const GAS unsigned long long* yr = (const GAS unsigned long long*)(y2 + (size_t)mr[r] * DM) + lane;
        rsv[r] = rsin[mr[r]];
#pragma unroll
        for (int j = 0; j < 4; ++j) { uu[r][j] = ur[64 * j]; yy[r][j] = yr[64 * j]; } }
#pragma unroll
    for (int r = 0; r < NR; ++r) { const float ir = __builtin_amdgcn_rcpf(rsv[r]); f32x4 v[4]; float s = 0.f;
#pragma unroll
        for (int j = 0; j < 4; ++j) { const unsigned al = (unsigned)uu[r][j], ah = (unsigned)(uu[r][j] >> 32), bl = (unsigned)yy[r][j], bh = (unsigned)(yy[r][j] >> 32);
            v[j] = (f32x4){blo(al), bhi(al), blo(ah), bhi(ah)} * ig1[j] * ir + (f32x4){blo(bl), bhi(bl), blo(bh), bhi(bh)}; s += (v[j].x * v[j].x + v[j].y * v[j].y) + (v[j].z * v[j].z + v[j].w * v[j].w); }
        const float rs = 1.0f / sqrtf(wave_sum(s) * (1.0f / DM) + EPS);
        GAS f32x4* orw = (GAS f32x4*)(out + (size_t)mr[r] * DM) + lane;
#pragma unroll
        for (int j = 0; j < 4; ++j) orw[64 * j] = v[j] * rs * gf[j]; }
}
__device__ __forceinline__ void rms_row_inplace_f32(GAS float* xrow, const GAS float* g, int lane) {
    GAS f32x4* xr = (GAS f32x4*)xrow + lane; const GAS f32x4* gr = (const GAS f32x4*)g + lane;
    f32x4 v[4]; float s = 0.f;
#pragma unroll
    for (int j = 0; j < 4; ++j) { v[j] = xr[64 * j]; s += (v[j].x * v[j].x + v[j].y * v[j].y) + (v[j].z * v[j].z + v[j].w * v[j].w); }
    const float rs = 1.0f / sqrtf(wave_sum(s) * (1.0f / DM) + EPS);
#pragma unroll
    for (int j = 0; j < 4; ++j) { const f32x4 gv = gr[64 * j]; xr[64 * j] = v[j] * rs * gv; }
}

#define RLX_AGENT __ATOMIC_RELAXED, __HIP_MEMORY_SCOPE_AGENT
#define XB_TMO      128
#define XB_XCNT(j)  (256  + 64 * (j))
#define XB_XSUB(j)  (1280 + 64 * (j))
#define XB_XGEN(j)  (2304 + 64 * (j))
#define XB_TOP      3328
#define XB_TOPGEN   3392
#define XCD_BAR_WORDS 3456
#define XB_SPIN_CAP (1u << 18)

__device__ __forceinline__ unsigned xb_ld(unsigned* p)              { return __hip_atomic_load(p, __ATOMIC_RELAXED, __HIP_MEMORY_SCOPE_AGENT); }
__device__ __forceinline__ unsigned xb_add(unsigned* p, unsigned v) { return __hip_atomic_fetch_add(p, v, __ATOMIC_RELAXED, __HIP_MEMORY_SCOPE_AGENT); }
__device__ __forceinline__ unsigned xb_xcc_id() { return (unsigned)__builtin_amdgcn_s_getreg((3 << 11) | 20) & 0xFu; }
#define XB_SPIN(cond, bar) do { unsigned _sp = 0; while (cond) { __builtin_amdgcn_s_sleep(1); \
    if ((++_sp & 255u) == 0u) { if (xb_ld(&(bar)[XB_TMO])) break; if (_sp > XB_SPIN_CAP) { atomicAdd(&(bar)[XB_TMO], 1u); break; } } } } while (0)

struct XcdBarrier {
    unsigned* bar; unsigned x;
    volatile LAS unsigned* st;
};

__device__ __forceinline__ XcdBarrier xcd_barrier_post(unsigned* bar, volatile LAS unsigned* st) {
    XcdBarrier b; b.bar = bar; b.x = xb_xcc_id(); b.st = st;
    if (threadIdx.x == 0) (void)xb_add(&bar[XB_XCNT(b.x)], 1u);
    return b;
}
__device__ __forceinline__ void xcd_barrier_complete(unsigned* bar, unsigned x, unsigned& nloc, unsigned& nx) {
    const unsigned G = gridDim.x * gridDim.y * gridDim.z;
    unsigned sum, cnt, mine, sp = 0u;
    for (;;) {
        sum = 0u; cnt = 0u; mine = 0u;
#pragma unroll
        for (unsigned j = 0; j < 16; ++j) { const unsigned c = xb_ld(&bar[XB_XCNT(j)]); sum += c; cnt += (c > 0u) ? 1u : 0u; mine = (j == x) ? c : mine; }
        if (sum == G) break;
        __builtin_amdgcn_s_sleep(1);
        if ((++sp & 255u) == 0u) { if (xb_ld(&bar[XB_TMO])) break; if (sp > XB_SPIN_CAP) { atomicAdd(&bar[XB_TMO], 1u); break; } }
    }
    nloc = mine > 0u ? mine : 1u; nx = cnt > 0u ? cnt : 1u;
}

__device__ __forceinline__ void xcd_barrier(const XcdBarrier& b) {
    asm volatile("s_waitcnt vmcnt(0)" ::: "memory");
    __syncthreads();
    if (threadIdx.x == 0) {
        unsigned* bar = b.bar;
        __builtin_amdgcn_s_waitcnt(0);
        unsigned nloc = b.st[0], nx = b.st[1];
        if (nloc == 0u) { xcd_barrier_complete(bar, b.x, nloc, nx); b.st[0] = nloc; b.st[1] = nx; }
        const unsigned old = xb_add(&bar[XB_XSUB(b.x)], 1u);
        const unsigned gen = old / nloc;
        if (old + 1u == (gen + 1u) * nloc) {
            __builtin_amdgcn_fence(__ATOMIC_RELEASE, "agent");
            asm volatile("s_waitcnt vmcnt(0)" ::: "memory");
            const unsigned og = xb_add(&bar[XB_TOP], 1u);
            const unsigned tg = og / nx;
            if (og + 1u == (tg + 1u) * nx) xb_add(&bar[XB_TOPGEN], 1u);
            else XB_SPIN(xb_ld(&bar[XB_TOPGEN]) == tg, bar);
            __builtin_amdgcn_fence(__ATOMIC_ACQUIRE, "agent");
            xb_add(&bar[XB_XGEN(b.x)], 1u);
            asm volatile("s_waitcnt vmcnt(0)" ::: "memory");
        } else {
            XB_SPIN(xb_ld(&bar[XB_XGEN(b.x)]) == gen, bar);
            __builtin_amdgcn_fence(__ATOMIC_ACQUIRE, "agent");
            asm volatile("s_waitcnt vmcnt(0)" ::: "memory");
        }
    }
    __syncthreads();
}

constexpr int CW_BAR = 1024;
constexpr size_t CTL_ZERO_BYTES = 32768;
#ifndef HGABL
#define HGABL 0
#endif
#ifndef PHPROF_MASK
#define PHPROF_MASK 0u
#endif
#ifndef AABL
#define AABL 0
#endif
#ifndef REPEAT_MASK
#define REPEAT_MASK 0u
#endif
constexpr float LOG2E = 1.4426950408889634f, LN2 = 0.6931471805599453f;
typedef short bf16x8 __attribute__((ext_vector_type(8)));
typedef short s16x4 __attribute__((ext_vector_type(4)));
typedef float f32x16 __attribute__((ext_vector_type(16)));
typedef unsigned u32x2v __attribute__((ext_vector_type(2)));
typedef short v4i16_t __attribute__((ext_vector_type(4)));
__device__ __forceinline__ unsigned cvtpk(float lo, float hi) { unsigned r; asm volatile("v_cvt_pk_bf16_f32 %0, %1, %2" : "=v"(r) : "v"(lo), "v"(hi)); return r; }
typedef float f32x2_t __attribute__((ext_vector_type(2))); typedef __bf16 bf16x2_t __attribute__((ext_vector_type(2)));
__device__ __forceinline__ unsigned cvtpk_c(float lo, float hi) { const f32x2_t v = {lo, hi}; const bf16x2_t b = __builtin_convertvector(v, bf16x2_t); return __builtin_bit_cast(unsigned, b); }
__device__ __forceinline__ bf16x8 pack8(float a0, float a1, float a2, float a3, float a4, float a5, float a6, float a7) {
    v4u w; w.x = cvtpk(a0, a1); w.y = cvtpk(a2, a3); w.z = cvtpk(a4, a5); w.w = cvtpk(a6, a7); return __builtin_bit_cast(bf16x8, w);
}
__device__ __forceinline__ int crow(int r) { return (r & 3) + 8 * (r >> 2); }
__device__ __forceinline__ s16x4 vtr(const LAS unsigned char* p) { return __builtin_bit_cast(s16x4, __builtin_amdgcn_ds_read_tr16_b64_v4i16((LAS v4i16_t*)p)); }
__device__ __forceinline__ void glds16(const GAS void* gsrc, unsigned lds_dst) { unsigned keep;
    asm volatile("s_mov_b32 %0, m0\n\ts_mov_b32 m0, %2\n\ts_nop 0\n\tglobal_load_lds_dwordx4 %1, off\n\ts_mov_b32 m0, %0" : "=&s"(keep) : "v"(gsrc), "s"(lds_dst) : "memory"); }
#define LDS_BAR() do { asm volatile("s_waitcnt lgkmcnt(0)" ::: "memory"); __builtin_amdgcn_s_barrier(); asm volatile("" ::: "memory"); } while (0)
#define VM_WAIT_N(n) asm volatile("s_waitcnt vmcnt(" #n ")" ::: "memory")

constexpr int H3_SLOT = 32768;
constexpr int H3_QF = 98304, H3_KIF = 106496, H3_KDF = 114688, H3_OB = 122880, H3_OBLD = 272  , H3_OBB = 32 * H3_OBLD  , H3_TT = H3_OB + 2 * H3_OBB, H3_AD = H3_TT + 2048, H3_FL = H3_AD + 512, H3_END = H3_FL + 16;
static_assert(H3_END <= TAB_OFF, "HGRN LDS map");
constexpr size_t WS_HGU = 67 * MiB, WS_HGA = 83 * MiB;
#ifndef PROF_SEL
#define PROF_SEL 0
#endif
#define PROF_T0(k) unsigned long long t0_##k = 0; if (PROF_SEL == k && OUT) { asm volatile("s_memrealtime %0\n\ts_waitcnt lgkmcnt(0)" : "=s"(t0_##k) :: "memory"); }
#define PROF_T1(k) if (PROF_SEL == k && OUT) { unsigned long long t1_; asm volatile("s_memrealtime %0\n\ts_waitcnt lgkmcnt(0)" : "=s"(t1_) :: "memory"); prof_acc += (unsigned)(t1_ - t0_##k); }
template <bool OUT, int ABL = 0>
__device__ __forceinline__ unsigned hgrn_pass(LAS unsigned char* lds, int item, int tid, const GAS bf16* __restrict__ qfig, const GAS float* __restrict__ lb_logits, const GAS float* __restrict__ norm_g, GAS float* __restrict__ Ust, GAS float* __restrict__ Ast, GAS bf16* __restrict__ y) {
    unsigned prof_acc = 0;
    const int h = item >> 4, J = item & 15;
    const int lane = tid & 63, w = __builtin_amdgcn_readfirstlane(tid >> 6), l15 = lane & 15, q4 = lane >> 4;
    const int col = 16 * w + l15, cq = q4;
    const int eg = 16 * w + l15;
    const unsigned lds0 = (unsigned)(size_t)lds;
    float lb;
    { const int gc = h * 128 + col; const float l0 = lb_logits[gc], l1 = lb_logits[DI + gc], l2 = lb_logits[2 * DI + gc];
      const float mx = fmaxf(l0, fmaxf(l1, l2)); const float e0 = __expf(l0 - mx), e1 = __expf(l1 - mx), e2 = __expf(l2 - mx); lb = e0 * __builtin_amdgcn_rcpf(e0 + e1 + e2); }
    const float omlb = 1.0f - lb;
    int off8[8];
    { const int ks = col >> 5, tq = (col >> 2) & 3, jjd = 4 * ((col >> 4) & 1) + (col & 3);
#pragma unroll
      for (int cc = 0; cc < 8; ++cc) { const int c = 8 * cq + cc; off8[cc] = c * 256 + (((ks * 4 + tq) ^ (c & 15)) * 16) + jjd * 2; } }
    f32x4 S[8];
#pragma unroll
    for (int dt = 0; dt < 8; ++dt) S[dt] = (f32x4){0.f, 0.f, 0.f, 0.f};
    if (OUT) {
        f32x4 P[8];
#pragma unroll
        for (int dt = 0; dt < 8; ++dt) P[dt] = (f32x4){1.f, 1.f, 1.f, 1.f};
        for (int Jp = J - 1; Jp >= 0; --Jp) { const GAS f32x4* Uf = (const GAS f32x4*)(Ust + (size_t)(h * 16 + Jp) * 16384) + (w * 8) * 64 + lane; const GAS float* Ab = Ast + (h * 16 + Jp) * 128;
            bool nz = false;
#pragma unroll
            for (int dt = 0; dt < 8; ++dt) { const f32x4 u = Uf[dt * 64]; const f32x4 a = *(const GAS f32x4*)(Ab + 16 * dt + 4 * q4); S[dt] += P[dt] * u; P[dt] *= a;
                nz = nz || (P[dt][0] != 0.f) || (P[dt][1] != 0.f) || (P[dt][2] != 0.f) || (P[dt][3] != 0.f); }
            if (!__any(nz)) break; }
    }
    const int pc = tid >> 4, pe = tid & 15;
    f32x4 ng0 = (f32x4){0.f, 0.f, 0.f, 0.f}, ng1 = ng0;
    if (OUT) { ng0 = *(const GAS f32x4*)(norm_g + h * 128 + 8 * pe); ng1 = *(const GAS f32x4*)(norm_g + h * 128 + 8 * pe + 4); }
    constexpr int ROWB = OUT ? 1024 : 512, H3_TQ = 0, H3_TF = OUT ? 256 : 0, H3_TV = OUT ? 512 : 256, H3_TG = 768;
    const GAS char* base = (const GAS char*)(qfig + ((size_t)h * SEQ + (size_t)(J * 1024)) * 512);
    const GAS char* dsrc = OUT ? base + (size_t)(4 * w) * 1024 + lane * 16 : base + (size_t)(4 * w + (lane >> 5)) * 1024 + 256 + (lane & 31) * 16;
#define HG_DMA(chunk_, slot_) do { const GAS char* s_ = dsrc + (size_t)(chunk_) * 32768; const unsigned d_ = lds0 + (unsigned)(slot_) * H3_SLOT + (unsigned)w * (4u * ROWB); \
        if (OUT) { glds16(s_, d_); glds16(s_ + 1024, d_ + 1024); glds16(s_ + 2048, d_ + 2048); glds16(s_ + 3072, d_ + 3072); } else { glds16(s_, d_); glds16(s_ + 2048, d_ + 1024); } } while (0)
    const int p1off = (8 * cq + (l15 >> 2)) * ROWB + (16 * w + 4 * (l15 & 3)) * 2;
    const int vfoff = (4 * q4 + (l15 >> 2)) * ROWB + (16 * w + 4 * (l15 & 3)) * 2;
    asm volatile("s_waitcnt vmcnt(0)" ::: "memory");
    float logP = 1.f;
    if (!OUT) { unsigned z; asm volatile("v_mov_b32 %0, 0" : "=v"(z));
        if (tid == 0) { ((LAS unsigned*)(lds + H3_FL))[0] = z; ((LAS unsigned*)(lds + H3_FL))[1] = z; } }
    HG_DMA(OUT ? 0 : 31, 0); HG_DMA(OUT ? 1 : 30, 1);
    if (OUT) VM_WAIT_N(4); else VM_WAIT_N(2);
    LDS_BAR();
#define HG_Y(ov, gn, g) ((ov) * rs * (gn) * (g) * __builtin_amdgcn_rcpf(1.0f + __builtin_amdgcn_exp2f((g) * -LOG2E)))
#define HG_FINISH(OBT_, G4_, NC_) do { const v4u ow_ = *(const LAS v4u*)((OBT_) + pc * H3_OBLD + pe * 16); \
        const float a0 = blo(ow_.x), a1 = bhi(ow_.x), a2 = blo(ow_.y), a3 = bhi(ow_.y), a4 = blo(ow_.z), a5 = bhi(ow_.z), a6 = blo(ow_.w), a7 = bhi(ow_.w); \
        float ss = (a0 * a0 + a1 * a1) + (a2 * a2 + a3 * a3) + (a4 * a4 + a5 * a5) + (a6 * a6 + a7 * a7); \
        ss += __shfl_xor(ss, 1); ss += __shfl_xor(ss, 2); ss += __shfl_xor(ss, 4); ss += __shfl_xor(ss, 8); \
        const float rs = __builtin_amdgcn_rsqf(ss * (1.0f / 128.0f) + EPS); \
        const float g0 = blo((G4_).x), g1 = bhi((G4_).x), g2 = blo((G4_).y), g3 = bhi((G4_).y), g4 = blo((G4_).z), g5 = bhi((G4_).z), g6 = blo((G4_).w), g7 = bhi((G4_).w); \
        v4u yo; yo.x = cvtpk(HG_Y(a0, ng0.x, g0), HG_Y(a1, ng0.y, g1)); yo.y = cvtpk(HG_Y(a2, ng0.z, g2), HG_Y(a3, ng0.w, g3)); \
        yo.z = cvtpk(HG_Y(a4, ng1.x, g4), HG_Y(a5, ng1.y, g5)); yo.w = cvtpk(HG_Y(a6, ng1.z, g6), HG_Y(a7, ng1.w, g7)); \
        *(GAS v4u*)(y + (size_t)(J * 1024 + (NC_) * 32 + pc) * DI + h * 128 + 8 * pe) = yo; } while (0)
    for (int it = 0; it < 32; ++it) {
        const int n = OUT ? it : 31 - it;
        const LAS unsigned char* slot = lds + (it % 3) * H3_SLOT;
        PROF_T0(1)
        v4u gw4 = (v4u){0u, 0u, 0u, 0u};
        if (OUT && it > 0) gw4 = *(const LAS v4u*)(lds + ((it - 1) % 3) * H3_SLOT + H3_TG + pc * ROWB + pe * 16);
        PROF_T1(1)
        PROF_T0(2)
        { float qv[8], kv[8], cs[8];
          const s16x4 f0 = vtr(slot + H3_TF + p1off), f1 = vtr(slot + H3_TF + p1off + 4 * ROWB);
          s16x4 q0 = (s16x4){0, 0, 0, 0}, q1 = q0; if (OUT) { q0 = vtr(slot + H3_TQ + p1off); q1 = vtr(slot + H3_TQ + p1off + 4 * ROWB); }
#pragma unroll
          for (int cc = 0; cc < 8; ++cc) {
              const float fp = bf2f((unsigned short)(cc < 4 ? f0[cc] : f1[cc - 4])); qv[cc] = OUT ? bf2f((unsigned short)(cc < 4 ? q0[cc] : q1[cc - 4])) : 0.f;
              const float f = __builtin_fmaf(omlb, __builtin_amdgcn_rcpf(1.0f + __builtin_amdgcn_exp2f(fp * -LOG2E)), lb);
              kv[cc] = 1.0f - f; cs[cc] = cc ? cs[cc - 1] * f : f; }
          const float T = cs[7];
          const float T1 = __shfl_up(T, 16), T2 = __shfl_up(T, 32), T3 = __shfl_up(T, 48);
          const float off = (cq > 0 ? T1 : 1.f) * (cq > 1 ? T2 : 1.f) * (cq > 2 ? T3 : 1.f);
          const float total = __shfl(off * T, 48 + l15);
          if (OUT) { if (cq == 0) ((LAS float*)(lds + H3_AD))[col] = total; }
          float kd[8];
          const float kbase = OUT ? total : logP * total;
#pragma unroll
          for (int cc = 0; cc < 8; ++cc) { const float eb = off * cs[cc], enb = __builtin_amdgcn_rcpf(eb);
              kd[cc] = kv[cc] * (kbase * enb);
              if (OUT) { const float qd = qv[cc] * eb, ki = kv[cc] * enb;
                  *(LAS unsigned short*)(lds + H3_QF + off8[cc]) = (unsigned short)cvtpk(qd, qd);
                  *(LAS unsigned short*)(lds + H3_KIF + off8[cc]) = (unsigned short)cvtpk(ki, ki); } }
          if (!OUT) { logP *= total;
              if (tid == 0) ((LAS unsigned*)(lds + H3_FL))[(it + 1) & 1] = 0u;
              if (logP != 0.0f) ((LAS unsigned*)(lds + H3_FL))[it & 1] = 1u; }
          const int i4 = 4 * (cq >> 1), qa = 2 * (cq & 1), sw = (col >> 2) & 3;
          u32x2v w0, w1;
          w0.x = cvtpk(kd[0], kd[1]); w0.y = cvtpk(kd[2], kd[3]); w1.x = cvtpk(kd[4], kd[5]); w1.y = cvtpk(kd[6], kd[7]);
          *(LAS u32x2v*)(lds + H3_KDF + col * 64 + ((qa ^ sw) * 16) + i4 * 2) = w0;
          *(LAS u32x2v*)(lds + H3_KDF + col * 64 + (((qa + 1) ^ sw) * 16) + i4 * 2) = w1; }
        PROF_T1(2)
        PROF_T0(3)
        LDS_BAR();
        PROF_T1(3)
        PROF_T0(4)
        { const int nx = it + 2 < 32 ? it + 2 : 31; HG_DMA(OUT ? nx : 31 - nx, (it + 2) % 3); }
        PROF_T1(4)
        PROF_T0(5)
        if (PROF_SEL == 7 && OUT) { __builtin_amdgcn_sched_barrier(0); }
        if (PROF_SEL == 8 && OUT) { asm volatile("s_waitcnt lgkmcnt(0)" ::: "memory"); }
        if (PROF_SEL == 9 && OUT) { prof_acc += (unsigned)__builtin_amdgcn_s_memrealtime() & 1u; }
        bf16x8 vfrag;
        { const s16x4 v0 = vtr(slot + H3_TV + vfoff), v1 = vtr(slot + H3_TV + vfoff + 16 * ROWB); vfrag = (bf16x8){v0[0], v0[1], v0[2], v0[3], v1[0], v1[1], v1[2], v1[3]}; }
        if (OUT) {
            if (it > 0) HG_FINISH(lds + H3_OB + ((it - 1) & 1) * H3_OBB, gw4, n - 1);
            bf16x8 qf[2][4], kif[2][4];
#pragma unroll
            for (int jt = 0; jt < 2; ++jt)
#pragma unroll
                for (int ks = 0; ks < 4; ++ks) { const int c = 16 * jt + l15; const int byte = c * 256 + (((ks * 4 + q4) ^ (c & 15)) * 16);
                    qf[jt][ks] = *(const LAS bf16x8*)(lds + H3_QF + byte); kif[jt][ks] = *(const LAS bf16x8*)(lds + H3_KIF + byte); }
            f32x4 sc[2][2];
#pragma unroll
            for (int i = 0; i < 2; ++i)
#pragma unroll
                for (int jt = 0; jt < 2; ++jt) sc[i][jt] = (f32x4){0.f, 0.f, 0.f, 0.f};
#pragma unroll
            for (int ks = 0; ks < 4; ++ks)
#pragma unroll
                for (int i = 0; i < 2; ++i)
#pragma unroll
                    for (int jt = 0; jt < 2; ++jt) sc[i][jt] = __builtin_amdgcn_mfma_f32_16x16x32_bf16(kif[i][ks], qf[jt][ks], sc[i][jt], 0, 0, 0);
            f32x4 o[2];
#pragma unroll
            for (int jt = 0; jt < 2; ++jt) { const int c = 16 * jt + l15; float pm[8];
#pragma unroll
                for (int r = 0; r < 4; ++r) { pm[r] = (4 * q4 + r <= c) ? sc[0][jt][r] : 0.f; pm[4 + r] = (16 + 4 * q4 + r <= c) ? sc[1][jt][r] : 0.f; }
                const bf16x8 pf = pack8(pm[0], pm[1], pm[2], pm[3], pm[4], pm[5], pm[6], pm[7]);
                o[jt] = __builtin_amdgcn_mfma_f32_16x16x32_bf16(pf, vfrag, (f32x4){0.f, 0.f, 0.f, 0.f}, 0, 0, 0); }
#pragma unroll
            for (int ks = 0; ks < 4; ++ks) { const bf16x8 sb = pack8(S[2 * ks][0], S[2 * ks][1], S[2 * ks][2], S[2 * ks][3], S[2 * ks + 1][0], S[2 * ks + 1][1], S[2 * ks + 1][2], S[2 * ks + 1][3]);
#pragma unroll
                for (int jt = 0; jt < 2; ++jt) o[jt] = __builtin_amdgcn_mfma_f32_16x16x32_bf16(qf[jt][ks], sb, o[jt], 0, 0, 0); }
#pragma unroll
            for (int jt = 0; jt < 2; ++jt)
#pragma unroll
                for (int r = 0; r < 4; ++r) *(LAS unsigned short*)(lds + H3_OB + (it & 1) * H3_OBB + (16 * jt + 4 * q4 + r) * H3_OBLD + eg * 2) = (unsigned short)cvtpk_c(o[jt][r], o[jt][r]);
        }
#pragma unroll
        for (int dt = 0; dt < 8; ++dt) { const int d = 16 * dt + l15;
            const bf16x8 kdf = *(const LAS bf16x8*)(lds + H3_KDF + d * 64 + ((q4 ^ ((d >> 2) & 3)) * 16));
            if (OUT) { const f32x4 av = *(const LAS f32x4*)(lds + H3_AD + (16 * dt + 4 * q4) * 4); S[dt] = __builtin_amdgcn_mfma_f32_16x16x32_bf16(kdf, vfrag, S[dt] * av, 0, 0, 0); }
            else S[dt] = __builtin_amdgcn_mfma_f32_16x16x32_bf16(kdf, vfrag, S[dt], 0, 0, 0); }
        if (!OUT) { if (((volatile LAS unsigned*)(lds + H3_FL))[it & 1] == 0u) break; }
        PROF_T1(5)
        PROF_T0(6)
        if (OUT) VM_WAIT_N(4); else VM_WAIT_N(2);
        LDS_BAR();
        PROF_T1(6)
    }
    if (OUT) {
        const v4u gl = *(const LAS v4u*)(lds + (31 % 3) * H3_SLOT + H3_TG + pc * ROWB + pe * 16);
        HG_FINISH(lds + H3_OB + (31 & 1) * H3_OBB, gl, 31);
    }
#undef HG_FINISH
#undef HG_Y
#undef HG_DMA
    asm volatile("s_waitcnt vmcnt(0)" ::: "memory");
    LDS_BAR();
    if (!OUT) {
        GAS f32x4* Uf = (GAS f32x4*)(Ust + (size_t)(h * 16 + J) * 16384) + (w * 8) * 64 + lane;
#pragma unroll
        for (int dt = 0; dt < 8; ++dt) Uf[dt * 64] = S[dt];
        if (cq == 0) Ast[(h * 16 + J) * 128 + col] = logP;
    }
    return prof_acc;
}
constexpr int A3_RT = 0, A3_RING = 1024, A3_NR = 5, A3_PD = 4, A3_SLOT = 16384, A3_STG = A3_RING + A3_NR * A3_SLOT, A3_STGB = 8192 + 256, A3_END = A3_STG + 8 * A3_STGB;
static_assert(A3_END <= TAB_OFF, "attention LDS map");
constexpr float QSCALE = 0.08838834764831845f * LOG2E;
__device__ __forceinline__ void glds4(const GAS void* gsrc, unsigned lds_dst) { unsigned keep;
    asm volatile("s_mov_b32 %0, m0\n\ts_mov_b32 m0, %2\n\ts_nop 0\n\tglobal_load_lds_dword %1, off\n\ts_mov_b32 m0, %0" : "=&s"(keep) : "v"(gsrc), "s"(lds_dst) : "memory"); }
__device__ __forceinline__ float mul_s(float a, float b) { float r; asm("v_mul_f32_e32 %0, %1, %2" : "=v"(r) : "v"(a), "v"(b)); return r; }
__device__ __forceinline__ float fma_s(float a, float b, float c) { float r; asm("v_fma_f32 %0, %1, %2, %3" : "=v"(r) : "v"(a), "v"(b), "v"(c)); return r; }
__device__ __forceinline__ void glds16s(const GAS void* sbase, unsigned voff, unsigned lds_dst) { unsigned keep;
    asm volatile("s_mov_b32 %0, m0\n\ts_mov_b32 m0, %3\n\ts_nop 0\n\tglobal_load_lds_dwordx4 %1, %2\n\ts_mov_b32 m0, %0" : "=&s"(keep) : "v"(voff), "s"(sbase), "s"(lds_dst) : "memory"); }
__device__ __forceinline__ void glds4s(const GAS void* sbase, unsigned voff, unsigned lds_dst) { unsigned keep;
    asm volatile("s_mov_b32 %0, m0\n\ts_mov_b32 m0, %3\n\ts_nop 0\n\tglobal_load_lds_dword %1, %2\n\ts_mov_b32 m0, %0" : "=&s"(keep) : "v"(voff), "s"(sbase), "s"(lds_dst) : "memory"); }
#ifndef APROF_W
#define APROF_W 0
#endif
#ifndef APROF_SEL
#define APROF_SEL 0
#endif
#define APROF_T0(k) unsigned long long at0_##k = 0; if (APROF_SEL == k) { asm volatile("s_memrealtime %0\n\ts_waitcnt lgkmcnt(0)" : "=s"(at0_##k) :: "memory"); }
#define APROF_T1(k) if (APROF_SEL == k) { unsigned long long t1_; asm volatile("s_memrealtime %0\n\ts_waitcnt lgkmcnt(0)" : "=s"(t1_) :: "memory"); aprof += (unsigned)(t1_ - at0_##k); }
__device__ __forceinline__ unsigned attn_phase(LAS unsigned char* lds, int vb, int G, int tid, const GAS bf16* __restrict__ qkv, const GAS float* __restrict__ rel_bias, GAS bf16* __restrict__ oacc_all, GAS float* __restrict__ lse_all, int g) {
    unsigned aprof = 0;
    const int lane = tid & 63, w = __builtin_amdgcn_readfirstlane(tid >> 6);
    const int ldil = 2 * g, dil = 1 << ldil, nqb = 512 >> ldil, L = SEQ >> ldil;
    LAS float* RT = (LAS float*)(lds + A3_RT);
    const unsigned lds0 = (unsigned)(size_t)lds;
    LAS unsigned char* stg = lds + A3_STG + w * A3_STGB;
    const unsigned stg0 = lds0 + A3_STG + (unsigned)w * A3_STGB;
    const int lq = (g == 2) ? 5 : 6, QPI = 1 << lq, ipb = 8192 >> lq, JN = QPI >> 3;
    for (int bi = vb; bi < 2 * ipb; bi += G) {
        APROF_T0(3)
        const int bat = bi >= ipb ? 1 : 0; GAS bf16* oacc = oacc_all + (size_t)bat * SEQ * DI; GAS float* lseacc = lse_all + (size_t)bat * SEQ * 16;
        const int it0 = (bi - bat * ipb) << lq; const int h = it0 >> 9; const int rres = (it0 & 511) >> (9 - ldil), mb0 = it0 & (nqb - 1);
        const int kt_lo = mb0 > 4 ? mb0 - 4 : 0, NS = mb0 + QPI - kt_lo;
        __syncthreads();
        { int t2 = tid; asm volatile("" : "+v"(t2));
          if (t2 < 191) { const int rel = 159 - t2; RT[t2] = (rel >= 0 && rel <= 128) ? rel_bias[(int)BUCKET[g][rel] * 48 + g * 16 + h] * LOG2E : -1e30f; } }
        asm volatile("s_waitcnt vmcnt(0)" ::: "memory");
        __syncthreads();
        const size_t rowbase = ((size_t)h * T + (size_t)bat * SEQ + (size_t)rres * L) * 256;
        const GAS char* qpl = (const GAS char*)qkv + rowbase;
        const GAS char* kpl = (const GAS char*)qkv + (size_t)16 * T * 256 + rowbase;
        const GAS char* vpl = (const GAS char*)qkv + (size_t)32 * T * 256 + rowbase;
#define A3_TILE(k_) do { int lt_ = lane; asm volatile("" : "+v"(lt_)); const int pr_ = lt_ >> 4, pp_ = lt_ & 15; \
            const int kro = (4 * w + pr_) * 256 + ((pp_ ^ ((4 * w + pr_) & 15)) * 16), vro = (4 * w + pr_) * 256 + ((pp_ ^ ((pr_ & 3) << 2)) * 16); \
            const int kk_ = (k_) < NS ? (k_) : NS - 1; const size_t to_ = (size_t)(kt_lo + kk_) * 8192; const unsigned sl_ = lds0 + A3_RING + (unsigned)((k_) % A3_NR) * A3_SLOT + (unsigned)w * 1024u; \
            glds16s(kpl + to_, (unsigned)kro, sl_); glds16s(vpl + to_, (unsigned)vro, sl_ + 8192u); } while (0)
#define A3_QDMA(mb_) do { int lt_ = lane; asm volatile("" : "+v"(lt_)); const int pr_ = lt_ >> 4, pp_ = lt_ & 15; _Pragma("unroll") for (int j_ = 0; j_ < 8; ++j_) glds16s(qpl + (size_t)(mb_) * 8192, (unsigned)((4 * j_ + pr_) * 256 + ((pp_ ^ ((4 * j_ + pr_) & 15)) * 16)), stg0 + j_ * 1024); } while (0)
#define A3_ODMA(mb_) do { int lt_ = lane; asm volatile("" : "+v"(lt_)); const int pr_ = lt_ >> 4, pp_ = lt_ & 15, ql_ = lt_ & 31; _Pragma("unroll") for (int j_ = 0; j_ < 8; ++j_) glds16s((const GAS char*)(oacc + ((size_t)h * SEQ + (size_t)(32 * (mb_) * dil + rres)) * 128), (unsigned)((4 * j_ + pr_) * dil * 256 + ((pp_ ^ ((4 * j_ + pr_) & 15)) * 16)), stg0 + j_ * 1024); \
            glds4s((const GAS char*)(lseacc + ((size_t)(32 * (mb_) * dil + rres)) * 16 + h), (unsigned)(ql_ * dil * 64), stg0 + 8192); } while (0)
        int jcur = 0, mb = mb0 + ((w & 3) * 2 + (w >> 2)), sstart = -1;
        int e0 = 0, e1 = 0, e2 = 0, e3 = 0;
        A3_QDMA(mb);
#pragma unroll
        for (int k = 0; k < A3_PD; ++k) A3_TILE(k);
        bf16x8 qf[8]; f32x16 o[4]; float m = -1e30f, l = 0.f;
#pragma unroll
        for (int ks = 0; ks < 8; ++ks) qf[ks] = (bf16x8){0, 0, 0, 0, 0, 0, 0, 0};
#pragma unroll
        for (int db = 0; db < 4; ++db)
#pragma unroll
            for (int r = 0; r < 16; ++r) o[db][r] = 0.f;
#define A3_START(NW_, kk_) do { VM_WAIT_N(NW_); int lx_ = lane; asm volatile("" : "+v"(lx_) :: "memory"); const int qx_ = lx_ & 31, hx_ = lx_ >> 5; \
            _Pragma("unroll") for (int ks = 0; ks < 8; ++ks) qf[ks] = *(const LAS bf16x8*)(stg + qx_ * 256 + (((2 * ks + hx_) ^ (qx_ & 15)) * 16)); \
            _Pragma("unroll") for (int db = 0; db < 4; ++db) _Pragma("unroll") for (int r = 0; r < 16; ++r) o[db][r] = 0.f; \
            m = -1e30f; l = 0.f; sstart = (kk_); asm volatile("s_waitcnt lgkmcnt(0)" ::: "memory"); if (g > 0) A3_ODMA(mb); } while (0)
        if ((mb > 4 ? mb - 4 : 0) == kt_lo) { A3_START(8, -1); if (g > 0) e3 = 9; }
        for (int k = 0; k <= NS; ++k) {
            const int kt = kt_lo + k;
            APROF_T0(1)
            APROF_T0(6)
            { const int ex = e0 + e1 + e2 + e3; if (ex == 0) VM_WAIT_N(6); else if (ex == 8) VM_WAIT_N(14); else if (ex == 9) VM_WAIT_N(15); else VM_WAIT_N(23); }
            APROF_T1(6)
            APROF_T0(7)
            e0 = e1; e1 = e2; e2 = e3; e3 = 0;
            LDS_BAR();
            APROF_T1(7)
            APROF_T1(1)
            APROF_T0(5)
            A3_TILE(k + A3_PD);
            APROF_T1(5)
            APROF_T0(2)
            const LAS unsigned char* slot = lds + A3_RING + (k % A3_NR) * A3_SLOT;
            const int first = mb > 4 ? mb - 4 : 0;
            if (jcur < JN && kt == first - 1) { APROF_T0(8) A3_START(4, k); if (g > 0) e3 = 9; APROF_T1(8) }
            else if (jcur < JN && kt >= first && kt <= mb) {
                APROF_T0(10)
                const int delta = mb - kt;
                int lx = lane; asm volatile("" : "+v"(lx));
                const int qx = lx & 31, hx = lx >> 5;
                f32x16 s;
                { const LAS float* rt = RT + (159 - (32 * delta + qx - 4 * hx));
#pragma unroll
                  for (int r = 0; r < 16; ++r) s[r] = rt[crow(r)]; }
#pragma unroll
                for (int kh = 0; kh < 4; ++kh) { bf16x8 kf[2];
#pragma unroll
                  for (int ks = 0; ks < 2; ++ks) kf[ks] = *(const LAS bf16x8*)(slot + qx * 256 + (((2 * (2 * kh + ks) + hx) ^ (qx & 15)) * 16));
#pragma unroll
                  for (int ks = 0; ks < 2; ++ks) s = __builtin_amdgcn_mfma_f32_32x32x16_bf16(kf[ks], qf[2 * kh + ks], s, 0, 0, 0); }
                float mx = s[0];
#pragma unroll
                for (int r = 1; r < 16; ++r) mx = fmaxf(mx, s[r]);
                { const auto sw = __builtin_amdgcn_permlane32_swap(__float_as_uint(mx), __float_as_uint(mx), false, false); mx = fmaxf(__uint_as_float(sw[0]), __uint_as_float(sw[1])); }
                if (kt == first) m = mx;
                else if (__any(mx > m + 8.0f)) { const float mn = fmaxf(m, mx); const float alpha = __builtin_amdgcn_exp2f(m - mn); m = mn; l *= alpha;
#pragma unroll
                    for (int db = 0; db < 4; ++db)
#pragma unroll
                        for (int r = 0; r < 16; ++r) o[db][r] *= alpha; }
                float rs = 0.f;
#pragma unroll
                for (int r = 0; r < 16; ++r) { s[r] = __builtin_amdgcn_exp2f(s[r] - m); rs += s[r]; }
                l += rs;
                const bf16x8 pb0 = pack8(s[0], s[1], s[2], s[3], s[4], s[5], s[6], s[7]), pb1 = pack8(s[8], s[9], s[10], s[11], s[12], s[13], s[14], s[15]);
                const int ix = lx & 15, gx = (lx >> 4) & 1;
#pragma unroll
                for (int db = 0; db < 4; ++db) {
                    const LAS unsigned char* vp = slot + (8192 + (4 * hx + (ix >> 2)) * 256 + ((4 * (db ^ (ix >> 2)) + 2 * gx + ((ix & 3) >> 1)) * 16) + (ix & 1) * 8); asm volatile("" : "+v"(vp));
                    const s16x4 a0 = vtr(vp), a1 = vtr(vp + 8 * 256);
                    const s16x4 b0 = vtr(vp + 16 * 256), b1 = vtr(vp + 24 * 256);
                    const bf16x8 va0 = (bf16x8){a0[0], a0[1], a0[2], a0[3], a1[0], a1[1], a1[2], a1[3]}, va1 = (bf16x8){b0[0], b0[1], b0[2], b0[3], b1[0], b1[1], b1[2], b1[3]};
                    o[db] = __builtin_amdgcn_mfma_f32_32x32x16_bf16(va0, pb0, o[db], 0, 0, 0);
                    o[db] = __builtin_amdgcn_mfma_f32_32x32x16_bf16(va1, pb1, o[db], 0, 0, 0);
                }
                APROF_T1(10)
            }
            else if (jcur < JN && kt == mb + 1) {
                APROF_T0(9)
                int lx = lane; asm volatile("" : "+v"(lx)); const int qx = lx & 31, hx = lx >> 5;
                { const auto sw = __builtin_amdgcn_permlane32_swap(__float_as_uint(l), __float_as_uint(l), false, false); l = __uint_as_float(sw[0]) + __uint_as_float(sw[1]); }
                const float lse = (m + __builtin_amdgcn_logf(l)) * LN2;
                float wa = 0.f, wg = __builtin_amdgcn_rcpf(l), ln = lse;
                if (g > 0) {
                    if (k - sstart == 6) VM_WAIT_N(12); else VM_WAIT_N(0);
                    asm volatile("" ::: "memory");
                    const float la = *(const LAS float*)(stg + 8192 + 4 * qx); const float mm = fmaxf(la, lse);
                    ln = mm + LN2 * __builtin_amdgcn_logf(__builtin_amdgcn_exp2f((la - mm) * LOG2E) + __builtin_amdgcn_exp2f((lse - mm) * LOG2E));
                    wa = __builtin_amdgcn_exp2f((la - ln) * LOG2E); wg = __builtin_amdgcn_exp2f((lse - ln) * LOG2E) * wg; }
                if (g > 0) {
#pragma unroll
                    for (int db = 0; db < 4; ++db) {
#pragma unroll
                        for (int rq = 0; rq < 4; ++rq) { LAS u32x2v* p = (LAS u32x2v*)(stg + qx * 256 + (((4 * db + rq) ^ (qx & 15)) * 16) + hx * 8); const u32x2v a = *p;
                            u32x2v rr; rr.x = cvtpk(fma_s(wa, blo(a.x), mul_s(wg, o[db][4 * rq + 0])), fma_s(wa, bhi(a.x), mul_s(wg, o[db][4 * rq + 1])));
                            rr.y = cvtpk(fma_s(wa, blo(a.y), mul_s(wg, o[db][4 * rq + 2])), fma_s(wa, bhi(a.y), mul_s(wg, o[db][4 * rq + 3])));
                            *p = rr; }
                        asm volatile("" ::: "memory"); }
                } else {
#pragma unroll
                    for (int db = 0; db < 4; ++db)
#pragma unroll
                        for (int rq = 0; rq < 4; ++rq) { LAS u32x2v* p = (LAS u32x2v*)(stg + qx * 256 + (((4 * db + rq) ^ (qx & 15)) * 16) + hx * 8);
                            u32x2v rr; rr.x = cvtpk(mul_s(wg, o[db][4 * rq + 0]), mul_s(wg, o[db][4 * rq + 1])); rr.y = cvtpk(mul_s(wg, o[db][4 * rq + 2]), mul_s(wg, o[db][4 * rq + 3]));
                            *p = rr; }
                }
                if (hx == 0) lseacc[((size_t)((32 * mb + qx) * dil + rres)) * 16 + h] = ln;
                asm volatile("s_waitcnt lgkmcnt(0)" ::: "memory");
                { const int pr_ = lx >> 4, pp_ = lx & 15; GAS char* ob = (GAS char*)(oacc + ((size_t)h * SEQ + (size_t)(32 * mb * dil + rres)) * 128);
#pragma unroll
                  for (int j = 0; j < 8; ++j) { const int rr = 4 * j + pr_; const v4u v = *(const LAS v4u*)(stg + rr * 256 + pp_ * 16);
                    *(GAS v4u*)(ob + (unsigned)(rr * dil * 256 + ((pp_ ^ (rr & 15)) * 16))) = v; if (j & 1) asm volatile("" ::: "memory"); } }
                asm volatile("s_waitcnt lgkmcnt(0)" ::: "memory");
                ++jcur; mb += 8;
                if (jcur < JN) { A3_QDMA(mb); e3 = 8; }
                APROF_T1(9)
            }
            APROF_T1(2)
        }
#undef A3_START
#undef A3_TILE
#undef A3_QDMA
#undef A3_ODMA
        asm volatile("s_waitcnt vmcnt(0)" ::: "memory");
        __syncthreads();
        APROF_T1(3)
#if APROF_SEL
        if (lane == 0) ((LAS unsigned*)(lds + 800))[w] = aprof;
#endif
    }
#if APROF_SEL
    __syncthreads(); aprof = ((LAS unsigned*)(lds + 800))[APROF_W]; __syncthreads();
#endif
    return aprof;
}
#ifndef FAST_HG
#define FAST_HG 1
#endif
#ifndef FAST_ATT
#define FAST_ATT 1
#endif
__device__ __forceinline__ GAS void* ldp(LAS unsigned char* lds, int i) {
    const unsigned long long v = ((LAS unsigned long long*)(lds + TAB_OFF))[i];
    const unsigned lo = __builtin_amdgcn_readfirstlane((unsigned)v), hi = __builtin_amdgcn_readfirstlane((unsigned)(v >> 32));
    return (GAS void*)(((unsigned long long)hi << 32) | lo);
}
struct Args { const float* in[10]; float* out; unsigned char* ws; int lo, hi; };
__global__ void __launch_bounds__(NWAVES * 64, 2) fwd(Args args) {
    extern __shared__ __attribute__((aligned(16))) unsigned char lds_raw[];
    LAS unsigned char* lds = (LAS unsigned char*)lds_raw;
    cg::grid_group grid = cg::this_grid();
    const int tid0 = threadIdx.x;
    const int G = gridDim.x; const int bx = blockIdx.x;
    const int vcu = (G % 8 == 0) ? (bx % 8) * (G / 8) + bx / 8 : bx;
    const int NGW = G * NWAVES;
    { LAS unsigned long long* P = (LAS unsigned long long*)(lds + TAB_OFF);
      if (tid0 < 10) P[tid0] = (unsigned long long)args.in[tid0];
      if (tid0 == 10) P[10] = (unsigned long long)args.out;
      if (tid0 == 11) P[11] = (unsigned long long)args.ws;
      if (tid0 == 12) { ((LAS unsigned*)(lds + TAB_OFF + 256))[0] = 0u; ((LAS unsigned*)(lds + TAB_OFF + 256))[1] = 0u; }
      __syncthreads(); }
    (void)xcd_barrier_post((unsigned*)(args.ws + WS_CTL) + CW_BAR, (volatile LAS unsigned*)(lds + TAB_OFF + 256));
    const int ph_hi = args.hi;
    unsigned prof_total = 0;
    int ph = args.lo, rep = 0;
    while (ph < ph_hi) {
        unsigned long long pht0 = 0; const int ph_cur = ph;
        if (PHPROF_MASK) { asm volatile("s_memrealtime %0\n\ts_waitcnt lgkmcnt(0)" : "=s"(pht0) :: "memory"); }
        int tid = threadIdx.x; asm volatile("" : "+v"(tid) :: "memory");
        const int lane = tid & 63, wave = __builtin_amdgcn_readfirstlane(tid >> 6), gw = vcu * NWAVES + wave;
        const GAS float* x = (const GAS float*)ldp(lds, 0); const GAS float* ln_g = (const GAS float*)ldp(lds, 1);
        GAS unsigned char* ws = (GAS unsigned char*)ldp(lds, 11); GAS float* Hres = (GAS float*)ldp(lds, 10); GAS bf16* U0 = (GAS bf16*)Hres;
        GAS bf16* Whgin = (GAS bf16*)(ws + WS_WHGIN); GAS bf16* Whgout = (GAS bf16*)(ws + WS_WHGOUT); GAS bf16* Wattin = (GAS bf16*)(ws + WS_WATTIN); GAS bf16* Wattout = (GAS bf16*)(ws + WS_WATTOUT);
        GAS bf16* QFIG = (GAS bf16*)(ws + WS_BIG0); GAS bf16* U1 = (GAS bf16*)(ws + WS_U1); GAS bf16* QKV = (GAS bf16*)(ws + WS_QKV); GAS bf16* YB = (GAS bf16*)(ws + WS_BIG1);
        if (ph == PH_PRO) {
            LAS unsigned char* scr = lds + wave * 16384;
            const GAS float* hg_w_in = (const GAS float*)ldp(lds, 2);
            constexpr int I_A = (DM / 64) * (HG_COLS / 64);
            for (int it = gw; it < I_A; it += NGW) p0_transpose_item(hg_w_in, DM, HG_COLS, Whgin, scr, it, lane, true);
            { f32x4 gv[4]; const GAS f32x4* gr = (const GAS f32x4*)ln_g + lane;
#pragma unroll
              for (int j = 0; j < 4; ++j) gv[j] = gr[64 * j];
              for (int m = gw; m < SEQ; m += NR * NGW) rms_rows_to_bf16(x, m, NGW, SEQ, gv, U0, lane); }
        } else if (ph == PH_G1_0 || ph == PH_G1_1) {
            const int b = (ph == PH_G1_1);
            const pg8::Gemm g{U0 + (size_t)b * SEQ * DM, Whgin, SEQ, HG_COLS, DM}; const pg8::EpiBf16 E{QFIG, 512, 0, 1.0f, SEQ, 0, SEQ};
            pg8::StaticOrder S; S.init(SEQ, HG_COLS, G, bx);
            pg8::gemm_phase<pg8::EpiBf16, pg8::StaticOrder, PG8_ALIGN, PG8_SP2>(lds, g, S, E);
        } else if (ph >= PH_G3_0 && ph < PH_GATE && ((ph - PH_G3_0) & 1) == 0) {
            const int gi = (ph - PH_G3_0) >> 1;
            const pg8::Gemm g{U1, Wattin + (size_t)gi * QKV_COLS * DM, T, QKV_COLS, DM}; const pg8::EpiBf16 E{QKV, QKV_COLS, DI, QSCALE, -T, 2 * gi, SEQ};
            pg8::StaticOrder S; S.init(T, QKV_COLS, G, bx);
            pg8::gemm_phase<pg8::EpiBf16, pg8::StaticOrder, PG8_ALIGN, PG8_SP2>(lds, g, S, E);
        } else if (ph == PH_G2 || ph == PH_G5) {
            pg8::Gemm g{ph == PH_G2 ? YB : (GAS bf16*)(ws + WS_Y2), ph == PH_G2 ? Whgout : Wattout, T, DM, DI};
            GAS bf16* yo = ph == PH_G2 ? (GAS bf16*)(ws + WS_Y1) : (GAS bf16*)(ws + WS_Y2P);
            const pg8::EpiBf16Split E{yo, yo + (size_t)SEQ * DM, DM, SEQ};
            pg8::StaticOrder S; S.init(T, DM, G, bx);
            pg8::gemm_phase<pg8::EpiBf16Split, pg8::StaticOrder, PG8_ALIGN, PG8_SP2>(lds, g, S, E);
        } else if (ph == PH_GATE) {
            pg8::Gemm g{U1, Wattin + (size_t)3 * QKV_COLS * DM, T, DI, DM};
            pg8::EpiGateMul E{(const GAS bf16*)Hres, (GAS bf16*)(ws + WS_Y2), DI, SEQ};
            pg8::StaticOrder S; S.init(T, DI, G, bx);
            pg8::gemm_phase<pg8::EpiGateMul, pg8::StaticOrder, PG8_ALIGN, PG8_SP2>(lds, g, S, E);
        } else if (ph == PH_HGA_0 || ph == PH_HGA_1 || ph == PH_HGB_0 || ph == PH_HGB_1) {
            const int b = (ph >= PH_G1_1); const bool outp = (ph == PH_HGB_0 || ph == PH_HGB_1);
            const GAS float* lbl = (const GAS float*)ldp(lds, 3); const GAS float* ngp = (const GAS float*)ldp(lds, 4);
#if FAST_HG
            GAS float* Ust = (GAS float*)(ws + WS_HGU); GAS float* Ast = (GAS float*)(ws + WS_HGA);
            for (int item = vcu; item < 256; item += G) {
                if (outp) prof_total += hgrn_pass<true>(lds, item, tid, QFIG, lbl, ngp, Ust, Ast, YB + (size_t)b * SEQ * DI);
                else hgrn_pass<false>(lds, item, tid, QFIG, lbl, ngp, Ust, Ast, YB + (size_t)b * SEQ * DI);
            }
            if (ph == PH_HGA_0) {
                LAS unsigned char* scr = lds + wave * 16384;
                const GAS float* hg_w_out = (const GAS float*)ldp(lds, 5); const GAS float* att_w_in = (const GAS float*)ldp(lds, 6); const GAS float* att_w_out = (const GAS float*)ldp(lds, 7);
                constexpr int I_B = (DI / 64) * (DM / 64), I_C = (DM / 64) * (ATT_COLS / 64), I_D = I_B;
                for (int it = gw; it < I_B + I_C + I_D; it += NGW) {
                    int r = it;
                    if (r < I_B) { p0_transpose_item(hg_w_out, DI, DM, Whgout, scr, r, lane); continue; } r -= I_B;
                    if (r < I_C) { p0_transpose_item(att_w_in, DM, ATT_COLS, Wattin, scr, r, lane); continue; } r -= I_C;
                    p0_transpose_item(att_w_out, DI, DM, Wattout, scr, r, lane);
                }
                { f32x4 gv[4]; const GAS f32x4* gr = (const GAS f32x4*)ln_g + lane;
#pragma unroll
                  for (int j = 0; j < 4; ++j) gv[j] = gr[64 * j];
                  for (int m = SEQ + gw; m < T; m += NR * NGW) rms_rows_to_bf16(x, m, NGW, T, gv, U0, lane); }
            }
#endif
        } else if (ph >= PH_G3_0 && ph < PH_GATE && ((ph - PH_G3_0) & 1) == 1) {
            const int gi = (ph - PH_G3_0) >> 1;
            prof_total += attn_phase(lds, vcu, G, tid, QKV, (const GAS float*)ldp(lds, 8), (GAS bf16*)Hres, (GAS float*)(ws + WS_LSE), gi);
        } else if (ph == PH_NORM1) {
            { f32x4 gv[4]; const GAS f32x4* gr = (const GAS f32x4*)(ln_g + DM) + lane;
#pragma unroll
              for (int j = 0; j < 4; ++j) gv[j] = gr[64 * j];
              const GAS bf16* Y1 = (const GAS bf16*)(ws + WS_Y1); GAS float* RS = (GAS float*)(ws + WS_RS);
              for (int m = gw; m < T; m += NR * NGW) rms_rows_xy_to_bf16(x, Y1, m, NGW, T, gv, U1, RS, lane); }
        } else if (ph == PH_FINAL) {
            f32x4 ig1[4], gf[4];
            { const GAS f32x4* g1r = (const GAS f32x4*)(ln_g + DM) + lane; const GAS f32x4* gfr = (const GAS f32x4*)ldp(lds, 9) + lane;
#pragma unroll
              for (int j = 0; j < 4; ++j) { const f32x4 gg = g1r[64 * j]; ig1[j] = (f32x4){1.0f / gg.x, 1.0f / gg.y, 1.0f / gg.z, 1.0f / gg.w}; gf[j] = gfr[64 * j]; } }
            { const GAS float* RS = (const GAS float*)(ws + WS_RS); const GAS bf16* Y2P = (const GAS bf16*)(ws + WS_Y2P);
              for (int m = gw; m < T; m += NR * NGW) rms_rows_final(U1, RS, Y2P, m, NGW, T, ig1, gf, Hres, lane); }
        }
        if (((REPEAT_MASK >> ph) & 1u) && rep == 0) rep = 1; else { rep = 0; ++ph; }
        if (ph < ph_hi) {
            if (ph_hi < 0) grid.sync();
            else { XcdBarrier xb; xb.bar = (unsigned*)((GAS unsigned char*)ldp(lds, 11) + WS_CTL) + CW_BAR; xb.x = xb_xcc_id(); xb.st = (volatile LAS unsigned*)(lds + TAB_OFF + 256); xcd_barrier(xb); }
        }
        if (PHPROF_MASK && ((PHPROF_MASK >> ph_cur) & 1u)) { unsigned long long t1_; asm volatile("s_memrealtime %0\n\ts_waitcnt lgkmcnt(0)" : "=s"(t1_) :: "memory"); prof_total += (unsigned)(t1_ - pht0); }
    }
#if PROF_SEL || APROF_SEL || PHPROF_MASK
    if (bx == 0 && threadIdx.x == 0) { const unsigned long long t0 = __builtin_amdgcn_s_memrealtime(); const unsigned long long want = 4ull * prof_total; while (__builtin_amdgcn_s_memrealtime() - t0 < want) __builtin_amdgcn_s_sleep(8); }
#endif
}

extern "C" void kernel_launch(void* const* d_in, const int* in_sizes, int n_in, void* d_out, int out_size, void* d_ws, size_t ws_size, hipStream_t stream) {
    static int grid = 0;
    if (grid == 0) {
        if (n_in != 10 || out_size != T * DM || ws_size < WS_END) { fprintf(stderr, "kernel_launch: unexpected shapes (n_in %d out %d ws %zu)\n", n_in, out_size, ws_size); grid = -1; return; }
        int dev = 0, cus = 0, per_cu = 0;
        hipGetDevice(&dev); hipDeviceGetAttribute(&cus, hipDeviceAttributeMultiprocessorCount, dev);
        if (hipFuncSetAttribute((const void*)fwd, hipFuncAttributeMaxDynamicSharedMemorySize, LDS_BYTES) != hipSuccess) { fprintf(stderr, "kernel_launch: hipFuncSetAttribute failed\n"); grid = -1; return; }
        hipOccupancyMaxActiveBlocksPerMultiprocessor(&per_cu, (const void*)fwd, NWAVES * 64, LDS_BYTES);
        if (per_cu < 1) { fprintf(stderr, "kernel_launch: occupancy query reports %d blocks per CU\n", per_cu); per_cu = 1; }
        (void)hipGetLastError();
        grid = cus * per_cu;
    }
    if (grid < 0) return;
    Args a{};
    for (int i = 0; i < 10; ++i) a.in[i] = (const float*)d_in[i];
    a.out = (float*)d_out; a.ws = (unsigned char*)d_ws;
    a.lo = PH_PRO; a.hi = PH_END;
    if (hipMemsetAsync((char*)d_ws + WS_CTL, 0, CTL_ZERO_BYTES, stream) != hipSuccess) { fprintf(stderr, "kernel_launch: hipMemsetAsync failed\n"); return; }
    void* kargs[] = {&a};
    const hipError_t le = hipLaunchCooperativeKernel((const void*)fwd, dim3(grid), dim3(NWAVES * 64), kargs, LDS_BYTES, stream);
    if (le != hipSuccess) fprintf(stderr, "kernel_launch: cooperative launch failed: %s (grid %d)\n", hipGetErrorString(le), grid);
}
```

```cpp
#include <hip/hip_runtime.h>
#include <hip/hip_cooperative_groups.h>
#include <cstdio>
#include <cstdint>
namespace cg = cooperative_groups;
namespace pg8 {
#define PG8_LAS __attribute__((address_space(3)))
typedef unsigned short bf16_t;
typedef short bf16x8 __attribute__((ext_vector_type(8)));
typedef float f32x4 __attribute__((ext_vector_type(4)));
typedef unsigned u32x4 __attribute__((ext_vector_type(4)));
constexpr int BM = 256, BK = 64, HALF = 128, HTB = HALF * BK * 2  , STAGE_BYTES = 8 * HTB, NXCD = 8, WGM = 8;

__host__ __device__ __forceinline__ int lds_byte(int r, int c) { const int st = (r >> 4) * 2 + (c >> 5), rr = r & 15, cc = c & 31, ob = rr * 64 + cc * 2; return st * 1024 + (ob ^ (((ob >> 9) & 1) << 5)); }
__host__ __device__ __forceinline__ void stage_rc(int b, int& R, int& C) { const int st = b / 1024, sb = b % 1024, swz = sb ^ (((sb >> 9) & 1) << 5); R = (st >> 1) * 16 + swz / 64; C = (st & 1) * 32 + (swz % 64) / 2; }
__host__ __device__ __forceinline__ int perm32(int rho) { const int n = rho >> 4, i = rho & 15; return 8 * (i >> 2) + 4 * n + (i & 3); }

struct Unit { int pm, pn; };
#define PG8_GAS __attribute__((address_space(1)))
struct Gemm { const PG8_GAS bf16_t* A; const PG8_GAS bf16_t* Bt; int M, N, K; };

struct StaticOrder {
    int nM, nN, nwg, G, c;
    __host__ __device__ void init(int M, int N, int G_, int c_) { nM = M / BM; nN = N / BM; nwg = nM * nN; G = G_; c = c_; }
    __host__ __device__ bool next(int i, Unit& u) const {
        const long L = (long)i * G + c; if (L >= nwg) return false;
        int wgid = (int)L; { const int q = nwg / NXCD, r = nwg % NXCD, xcd = wgid % NXCD, off = wgid / NXCD; wgid = (xcd < r ? xcd * (q + 1) : r * (q + 1) + (xcd - r) * q) + off; }
        const int nig = WGM * nN, gid = wgid / nig, fm = gid * WGM, gsz = (nM - fm) < WGM ? (nM - fm) : WGM;
        u.pm = fm + ((wgid % nig) % gsz); u.pn = (wgid % nig) / gsz; return true;
    }
    __device__ __forceinline__ void a_ready(const Unit&) const {}
    __device__ __forceinline__ void done(const Unit&) const {}
};

__device__ __forceinline__ unsigned cvt_pk_bf16(float lo, float hi) { unsigned r; asm volatile("v_cvt_pk_bf16_f32 %0, %1, %2" : "=v"(r) : "v"(lo), "v"(hi)); return r; }
typedef float f32x2 __attribute__((ext_vector_type(2)));
__device__ __forceinline__ float bf_lo(unsigned w) { return __uint_as_float(w << 16); }
__device__ __forceinline__ float bf_hi(unsigned w) { return __uint_as_float(w & 0xffff0000u); }
struct EpiBf16 {
    static constexpr bool PERM = true, AFTER_DRAIN = false;
    PG8_GAS bf16_t* O; int ldc; int qcols; float qscale; int hmajor; int ldil; int seq;
    __device__ __forceinline__ void operator()(const f32x4 (&acc)[2][2][4][2], const Unit& u, int wr, int wc, int fr, int fq) const {
        const int row0 = u.pm * BM + wr * 64 + fr, col0 = u.pn * BM + wc * 32 + 8 * fq;
        const float sc = (u.pn * BM < qcols) ? qscale : 1.0f;
        PG8_GAS bf16_t* Ob = O; int cb = col0;
        if (hmajor > 0) { Ob = O + (size_t)(u.pn >> 1) * ((size_t)hmajor * 512); cb = (u.pn & 1) * BM + wc * 32 + 8 * fq; }
        if (hmajor < 0) {
            const int nrow = -hmajor, Lr = seq >> ldil, dm = (1 << ldil) - 1; const int bb = (u.pm * BM) / seq, boff = bb * seq;
#pragma unroll
            for (int ai = 0; ai < 2; ++ai)
#pragma unroll
                for (int m = 0; m < 4; ++m) { const int t = row0 + ai * HALF + m * 16 - boff; const size_t ri = (size_t)boff + (size_t)(t & dm) * Lr + (t >> ldil);
#pragma unroll
                    for (int bj = 0; bj < 2; ++bj) { const f32x4 v0 = acc[ai][bj][m][0] * sc, v1 = acc[ai][bj][m][1] * sc;
                        u32x4 w; w.x = cvt_pk_bf16(v0[0], v0[1]); w.y = cvt_pk_bf16(v0[2], v0[3]); w.z = cvt_pk_bf16(v1[0], v1[1]); w.w = cvt_pk_bf16(v1[2], v1[3]);
                        *(PG8_GAS u32x4*)(O + (((size_t)((u.pn >> 3) * 16 + 2 * (u.pn & 7) + bj) * nrow + ri) * 128 + wc * 32 + 8 * fq)) = w; } }
            return; }
#pragma unroll
        for (int ai = 0; ai < 2; ++ai)
#pragma unroll
            for (int m = 0; m < 4; ++m) { PG8_GAS bf16_t* rowp = Ob + (size_t)(row0 + ai * HALF + m * 16) * ldc + cb;
#pragma unroll
                for (int bj = 0; bj < 2; ++bj) { const f32x4 v0 = acc[ai][bj][m][0] * sc, v1 = acc[ai][bj][m][1] * sc;
                    u32x4 w; w.x = cvt_pk_bf16(v0[0], v0[1]); w.y = cvt_pk_bf16(v0[2], v0[3]); w.z = cvt_pk_bf16(v1[0], v1[1]); w.w = cvt_pk_bf16(v1[2], v1[3]);
                    *(PG8_GAS u32x4*)(rowp + bj * HALF) = w; } }
    }
};
struct EpiBf16Split {
    static constexpr bool PERM = true, AFTER_DRAIN = false;
    PG8_GAS bf16_t* O; PG8_GAS bf16_t* O2; int ldc; int split;
    __device__ __forceinline__ void operator()(const f32x4 (&acc)[2][2][4][2], const Unit& u, int wr, int wc, int fr, int fq) const {
        const int row0 = u.pm * BM + wr * 64 + fr, col0 = u.pn * BM + wc * 32 + 8 * fq;
        PG8_GAS bf16_t* Ob = (u.pm * BM < split) ? O : O2 - (size_t)split * ldc;
#pragma unroll
        for (int ai = 0; ai < 2; ++ai)
#pragma unroll
            for (int m = 0; m < 4; ++m) { PG8_GAS bf16_t* rowp = Ob + (size_t)(row0 + ai * HALF + m * 16) * ldc + col0;
#pragma unroll
                for (int bj = 0; bj < 2; ++bj) { const f32x4 v0 = acc[ai][bj][m][0], v1 = acc[ai][bj][m][1];
                    u32x4 w; w.x = cvt_pk_bf16(v0[0], v0[1]); w.y = cvt_pk_bf16(v0[2], v0[3]); w.z = cvt_pk_bf16(v1[0], v1[1]); w.w = cvt_pk_bf16(v1[2], v1[3]);
                    *(PG8_GAS u32x4*)(rowp + bj * HALF) = w; } }
    }
};
struct EpiResF32 {
    static constexpr bool PERM = false, AFTER_DRAIN = false;
    const PG8_GAS float* base; PG8_GAS float* out; int ldc;
    __device__ __forceinline__ void operator()(const f32x4 (&acc)[2][2][4][2], const Unit& u, int wr, int wc, int fr, int fq) const {
        const int row0 = u.pm * BM + wr * 64 + fr, col0 = u.pn * BM + wc * 32 + 4 * fq;
#pragma unroll
        for (int ai = 0; ai < 2; ++ai)
#pragma unroll
            for (int m = 0; m < 4; ++m) { const size_t off = (size_t)(row0 + ai * HALF + m * 16) * ldc + col0;
#pragma unroll
                for (int bj = 0; bj < 2; ++bj)
#pragma unroll
                    for (int n = 0; n < 2; ++n) { const f32x4 b = *(const PG8_GAS f32x4*)(base + off + bj * HALF + n * 16); *(PG8_GAS f32x4*)(out + off + bj * HALF + n * 16) = b + acc[ai][bj][m][n]; } }
    }
};
struct EpiGateMul {
    static constexpr bool PERM = true, AFTER_DRAIN = false;
    const PG8_GAS bf16_t* OH; PG8_GAS bf16_t* Y; int ldc; int seq;
    __device__ __forceinline__ f32x2 sg2(f32x2 o, f32x2 g) const { const f32x2 t = g * (-1.4426950408889634f); f32x2 e; e.x = __builtin_amdgcn_exp2f(t.x); e.y = __builtin_amdgcn_exp2f(t.y);
        const f32x2 d = e + 1.0f; f32x2 r; r.x = __builtin_amdgcn_rcpf(d.x); r.y = __builtin_amdgcn_rcpf(d.y); return (o * g) * r; }
    __device__ __forceinline__ void operator()(const f32x4 (&acc)[2][2][4][2], const Unit& u, int wr, int wc, int fr, int fq) const {
        const int row0 = u.pm * BM + wr * 64 + fr, col0 = u.pn * BM + wc * 32 + 8 * fq;
        const int b = (u.pm * BM) / seq;
        const PG8_GAS bf16_t* ob = OH + ((size_t)(b * 16 + 2 * u.pn) * seq + (size_t)(row0 - b * seq)) * 128 + wc * 32 + 8 * fq;
        u32x4 ov[2][4][2];
#pragma unroll
        for (int ai = 0; ai < 2; ++ai)
#pragma unroll
            for (int m = 0; m < 4; ++m)
#pragma unroll
                for (int bj = 0; bj < 2; ++bj) ov[ai][m][bj] = __builtin_nontemporal_load((const PG8_GAS u32x4*)(ob + ((size_t)bj * seq + (size_t)(ai * HALF + m * 16)) * 128));
#pragma unroll
        for (int ai = 0; ai < 2; ++ai)
#pragma unroll
            for (int m = 0; m < 4; ++m) { PG8_GAS bf16_t* rowp = Y + (size_t)(row0 + ai * HALF + m * 16) * ldc + col0;
#pragma unroll
                for (int bj = 0; bj < 2; ++bj) { const f32x4 v0 = acc[ai][bj][m][0], v1 = acc[ai][bj][m][1]; const u32x4 o4 = ov[ai][m][bj];
                    const f32x2 a = sg2((f32x2){bf_lo(o4.x), bf_hi(o4.x)}, (f32x2){v0[0], v0[1]}), bq = sg2((f32x2){bf_lo(o4.y), bf_hi(o4.y)}, (f32x2){v0[2], v0[3]});
                    const f32x2 c = sg2((f32x2){bf_lo(o4.z), bf_hi(o4.z)}, (f32x2){v1[0], v1[1]}), d = sg2((f32x2){bf_lo(o4.w), bf_hi(o4.w)}, (f32x2){v1[2], v1[3]});
                    u32x4 w; w.x = cvt_pk_bf16(a.x, a.y); w.y = cvt_pk_bf16(bq.x, bq.y); w.z = cvt_pk_bf16(c.x, c.y); w.w = cvt_pk_bf16(d.x, d.y);
                    *(PG8_GAS u32x4*)(rowp + bj * HALF) = w; } }
    }
};
template <class Epi, class Sched, bool ALIGN_EPI = false, bool SP2 = false>
__device__ __forceinline__ void gemm_phase(PG8_LAS unsigned char* lds, const Gemm g, const Sched& S, const Epi& E) {
    int tid_ = threadIdx.x; asm volatile("" : "+v"(tid_));
    const int tid = tid_, wid = __builtin_amdgcn_readfirstlane(tid >> 6), lane = tid & 63, wr = wid >> 2, wc = wid & 3, fr = lane & 15, fq = lane >> 4;
    const int K = g.K, nt = K / BK;
    unsigned voffA[2], voffB[2];
#pragma unroll
    for (int i = 0; i < 2; ++i) { int R, C; stage_rc(tid * 16 + i * 8192, R, C); const int Rb = Epi::PERM ? ((R & ~31) + perm32(R & 31)) : R;
        voffA[i] = (unsigned)(R * K + C) * 2u; voffB[i] = (unsigned)(Rb * K + C) * 2u; }
    const size_t kstep = (size_t)(BK * 2);
    const size_t hstep = (size_t)HALF * K * 2;
    const size_t tstep = 2 * hstep;
    const unsigned ldsw = (unsigned)wid * 1024u;
    const int aoff = lds_byte(wr * 64 + fr, fq * 8), boff = lds_byte(wc * 32 + fr, fq * 8);
#define PG8_SA(b, h) (((b) * 2 + (h)) * HTB)
#define PG8_SB(b, h) ((4 + (b) * 2 + (h)) * HTB)
#define PG8_STAGE(bufoff, gbase, voff) do { _Pragma("unroll") for (int _i = 0; _i < 2; ++_i) \
        __builtin_amdgcn_global_load_lds((const PG8_GAS unsigned*)((const PG8_GAS char*)(gbase) + (voff)[_i]), (PG8_LAS unsigned*)(lds + (bufoff) + ldsw + _i * 8192), 16, 0, 0); } while (0)
#define PG8_LDA(dst, b, h) do { _Pragma("unroll") for (int m = 0; m < 4; ++m) _Pragma("unroll") for (int k = 0; k < 2; ++k) dst[m][k] = *(const PG8_LAS bf16x8*)(lds + PG8_SA(b, h) + aoff + m * 2048 + k * 1024); } while (0)
#define PG8_LDB(dst, b, h) do { _Pragma("unroll") for (int n = 0; n < 2; ++n) _Pragma("unroll") for (int k = 0; k < 2; ++k) dst[n][k] = *(const PG8_LAS bf16x8*)(lds + PG8_SB(b, h) + boff + n * 2048 + k * 1024); } while (0)
#define PG8_MMA(ai, bj, At, Bt) do { __builtin_amdgcn_s_setprio(1); _Pragma("unroll") for (int m = 0; m < 4; ++m) _Pragma("unroll") for (int n = 0; n < 2; ++n) _Pragma("unroll") for (int k = 0; k < 2; ++k) \
        acc[ai][bj][m][n] = __builtin_amdgcn_mfma_f32_16x16x32_bf16(Bt[n][k], At[m][k], acc[ai][bj][m][n], 0, 0, 0); __builtin_amdgcn_s_setprio(0); } while (0)
#define PG8_WAIT_V(n) asm volatile("s_waitcnt vmcnt(" #n ")" ::: "memory")
#define PG8_WAIT_L(n) asm volatile("s_waitcnt lgkmcnt(" #n ")" ::: "memory")
#define PG8_BAR __builtin_amdgcn_s_barrier()
#define PG8_SCHED __builtin_amdgcn_sched_barrier(0)
    Unit cur, nxt; int ui = 0;
    if (!S.next(0, cur)) return;
    f32x4 acc[2][2][4][2];
#pragma unroll
    for (int a = 0; a < 2; ++a)
#pragma unroll
        for (int b = 0; b < 2; ++b)
#pragma unroll
            for (int m = 0; m < 4; ++m)
#pragma unroll
                for (int n = 0; n < 2; ++n) acc[a][b][m][n] = (f32x4){0.f, 0.f, 0.f, 0.f};
    bf16x8 At[4][2], B0[2][2], B1[2][2];
    const PG8_GAS char* cA = (const PG8_GAS char*)g.A + (size_t)cur.pm * tstep; const PG8_GAS char* cB = (const PG8_GAS char*)g.Bt + (size_t)cur.pn * tstep;
    S.a_ready(cur);
    if constexpr (SP2) {
        PG8_STAGE(PG8_SB(0, 0), cB, voffB); PG8_STAGE(PG8_SB(0, 1), cB + hstep, voffB); PG8_STAGE(PG8_SA(0, 0), cA, voffA); PG8_STAGE(PG8_SA(0, 1), cA + hstep, voffA);
        if (wr == 1) PG8_BAR;
        PG8_WAIT_V(2); PG8_BAR;
        PG8_STAGE(PG8_SB(1, 0), cB + kstep, voffB); PG8_STAGE(PG8_SA(1, 0), cA + kstep, voffA); PG8_STAGE(PG8_SB(1, 1), cB + hstep + kstep, voffB);
        PG8_WAIT_V(6); PG8_BAR;
    } else {
        PG8_STAGE(PG8_SB(0, 0), cB, voffB); PG8_STAGE(PG8_SA(0, 0), cA, voffA); PG8_STAGE(PG8_SB(0, 1), cB + hstep, voffB); PG8_STAGE(PG8_SA(0, 1), cA + hstep, voffA);
        if (wr == 1) PG8_BAR;
        PG8_WAIT_V(4); PG8_BAR;
        PG8_STAGE(PG8_SB(1, 0), cB + kstep, voffB); PG8_STAGE(PG8_SA(1, 0), cA + kstep, voffA); PG8_STAGE(PG8_SB(1, 1), cB + hstep + kstep, voffB);
        PG8_WAIT_V(6); PG8_BAR;
    }
    for (;;) {
        const bool has_next = S.next(ui + 1, nxt);
        const PG8_GAS char* nA = has_next ? (const PG8_GAS char*)g.A + (size_t)nxt.pm * tstep : cA; const PG8_GAS char* nB = has_next ? (const PG8_GAS char*)g.Bt + (size_t)nxt.pn * tstep : cB;
        asm volatile(".p2align 8");
        for (int t = 0; t < nt; t += 2) {
            const bool last = (t == nt - 2);
            const PG8_GAS char* a1 = cA + (size_t)(t + 1) * kstep;
            const PG8_GAS char* a2 = last ? nA : cA + (size_t)(t + 2) * kstep; const PG8_GAS char* b2 = last ? nB : cB + (size_t)(t + 2) * kstep;
            const PG8_GAS char* a3 = a2 + kstep; const PG8_GAS char* b3 = b2 + kstep;
            if (last && has_next) S.a_ready(nxt);
            if constexpr (SP2) {
            PG8_LDB(B0, 0, 0); PG8_LDB(B1, 0, 1); PG8_SCHED; PG8_LDA(At, 0, 0); PG8_STAGE(PG8_SA(1, 1), a1 + hstep, voffA);
            PG8_WAIT_V(8); PG8_WAIT_L(0); PG8_BAR; PG8_MMA(0, 0, At, B0); PG8_MMA(0, 1, At, B1); PG8_BAR; PG8_SCHED;
            PG8_LDA(At, 0, 1); PG8_STAGE(PG8_SB(0, 0), b2, voffB); PG8_STAGE(PG8_SB(0, 1), b2 + hstep, voffB); PG8_STAGE(PG8_SA(0, 0), a2, voffA);
            PG8_WAIT_V(8); PG8_WAIT_L(0); PG8_BAR; PG8_MMA(1, 0, At, B0); PG8_MMA(1, 1, At, B1); PG8_BAR; PG8_SCHED;
            PG8_LDB(B0, 1, 0); PG8_LDB(B1, 1, 1); PG8_SCHED; PG8_LDA(At, 1, 0); PG8_STAGE(PG8_SA(0, 1), a2 + hstep, voffA);
            PG8_WAIT_V(8); PG8_WAIT_L(0); PG8_BAR; PG8_MMA(0, 0, At, B0); PG8_MMA(0, 1, At, B1); PG8_BAR; PG8_SCHED;
            PG8_LDA(At, 1, 1); PG8_STAGE(PG8_SB(1, 0), b3, voffB); PG8_STAGE(PG8_SB(1, 1), b3 + hstep, voffB); PG8_STAGE(PG8_SA(1, 0), a3, voffA);
            PG8_WAIT_V(8); PG8_WAIT_L(0); PG8_BAR; PG8_MMA(1, 0, At, B0); PG8_MMA(1, 1, At, B1); PG8_BAR; PG8_SCHED;
            } else {
            PG8_LDB(B0, 0, 0); PG8_SCHED; PG8_LDA(At, 0, 0); PG8_STAGE(PG8_SA(1, 1), a1 + hstep, voffA);
            PG8_WAIT_L(8); PG8_BAR; PG8_WAIT_L(0); PG8_MMA(0, 0, At, B0); PG8_BAR; PG8_SCHED;
            PG8_LDB(B1, 0, 1); PG8_STAGE(PG8_SB(0, 0), b2, voffB);
            PG8_BAR; PG8_WAIT_L(0); PG8_MMA(0, 1, At, B1); PG8_BAR;
            PG8_LDA(At, 0, 1); PG8_STAGE(PG8_SA(0, 0), a2, voffA);
            PG8_BAR; PG8_WAIT_L(0); PG8_MMA(1, 0, At, B0); PG8_BAR; PG8_SCHED;
            PG8_STAGE(PG8_SB(0, 1), b2 + hstep, voffB);
            PG8_WAIT_V(6); PG8_BAR; PG8_MMA(1, 1, At, B1); PG8_BAR;
            PG8_LDB(B0, 1, 0); PG8_SCHED; PG8_LDA(At, 1, 0); PG8_STAGE(PG8_SA(0, 1), a2 + hstep, voffA);
            PG8_WAIT_L(8); PG8_BAR; PG8_WAIT_L(0); PG8_MMA(0, 0, At, B0); PG8_BAR; PG8_SCHED;
            PG8_LDB(B1, 1, 1); PG8_STAGE(PG8_SB(1, 0), b3, voffB);
            PG8_BAR; PG8_WAIT_L(0); PG8_MMA(0, 1, At, B1); PG8_BAR;
            PG8_LDA(At, 1, 1); PG8_STAGE(PG8_SA(1, 0), a3, voffA);
            PG8_BAR; PG8_WAIT_L(0); PG8_MMA(1, 0, At, B0); PG8_BAR; PG8_SCHED;
            PG8_STAGE(PG8_SB(1, 1), b3 + hstep, voffB);
            PG8_WAIT_V(6); PG8_BAR; PG8_MMA(1, 1, At, B1); PG8_BAR;
            }
        }
        if constexpr (ALIGN_EPI) { if (wr == 0) PG8_BAR; }
        if constexpr (!Epi::AFTER_DRAIN) { E(acc, cur, wr, wc, fr, fq); S.done(cur); }
        if (!has_next) break;
#pragma unroll
        for (int a = 0; a < 2; ++a)
#pragma unroll
            for (int b = 0; b < 2; ++b)
#pragma unroll
                for (int m = 0; m < 4; ++m)
#pragma unroll
                    for (int n = 0; n < 2; ++n) acc[a][b][m][n] = (f32x4){0.f, 0.f, 0.f, 0.f};
        cur = nxt; cA = nA; cB = nB; ++ui;
        if constexpr (ALIGN_EPI) { if (wr == 1) PG8_BAR; }
    }
    PG8_WAIT_V(0);
    if constexpr (!ALIGN_EPI) { if (wr == 0) PG8_BAR; }
    PG8_BAR;
    if constexpr (Epi::AFTER_DRAIN) { E.fused(acc, cur, wr, wc, fr, fq, lds, wid, lane); S.done(cur); }
#undef PG8_SA
#undef PG8_SB
#undef PG8_STAGE
#undef PG8_LDA
#undef PG8_LDB
#undef PG8_MMA
#undef PG8_WAIT_V
#undef PG8_WAIT_L
#undef PG8_BAR
#undef PG8_SCHED
}
}
#ifndef PG8_SP2
#define PG8_SP2 true
#endif
#ifndef PG8_ALIGN
#define PG8_ALIGN true
#endif
constexpr int NWAVES = 8;
constexpr int BATCH = 2, SEQ = 16384, DM = 1024, DI = 2048, T = BATCH * SEQ;
constexpr int HG_COLS = 4 * DI;
constexpr int ATT_COLS = 10 * DI;
constexpr int QKV_COLS = 3 * DI;
constexpr float EPS = 1e-6f;
constexpr size_t MiB = 1u << 20;
constexpr size_t WS_CTL = 0;
constexpr size_t WS_WATTIN = 1 * MiB, WS_WATTOUT = 41 * MiB, WS_WHGOUT = 45 * MiB, WS_WHGIN = 49 * MiB;
constexpr size_t WS_LSE = 109 * MiB;
constexpr size_t WS_RS0 = 500 * MiB;
constexpr size_t WS_RS = 111 * MiB;
constexpr size_t WS_Y1 = 112 * MiB;
constexpr size_t WS_Y2 = 112 * MiB, WS_Y2P = 240 * MiB;
constexpr size_t WS_BIG0 = 96 * MiB;
constexpr size_t WS_U1 = 45 * MiB, WS_QKV = 112 * MiB;
constexpr size_t WS_BIG1 = 352 * MiB;
constexpr size_t WS_END = 512 * MiB;
constexpr int RING_BYTES = 131072;
constexpr int LDS_BYTES = 155648;
constexpr int TAB_OFF = 153600;
enum { PH_PRO = 0, PH_G1_0 = 1, PH_HGA_0 = 2, PH_HGB_0 = 3, PH_G1_1 = 4, PH_HGA_1 = 5, PH_HGB_1 = 6, PH_G2 = 7, PH_NORM1 = 8, PH_G3_0 = 9  , PH_GATE = 15, PH_G5 = 16, PH_FINAL = 17, PH_END = 18 };

#define LAS __attribute__((address_space(3)))
#define GAS __attribute__((address_space(1)))
typedef unsigned short bf16;
typedef unsigned v4u __attribute__((ext_vector_type(4)));
typedef float f32x4 __attribute__((ext_vector_type(4)));
typedef short s16x4t __attribute__((ext_vector_type(4)));
typedef short v4i16t __attribute__((ext_vector_type(4)));
#define LDS_WAIT() asm volatile("s_waitcnt lgkmcnt(0)" ::: "memory")
__device__ __forceinline__ unsigned f2bf(float f) { unsigned u = __builtin_bit_cast(unsigned, f); return (u + 0x7fffu + ((u >> 16) & 1u)) >> 16; }
__device__ __forceinline__ unsigned pk2(float lo, float hi) { return f2bf(lo) | (f2bf(hi) << 16); }
__device__ __forceinline__ float bf2f(unsigned short b) { return __uint_as_float(((unsigned)b) << 16); }
__device__ __forceinline__ float blo(unsigned w) { return __uint_as_float(w << 16); }
__device__ __forceinline__ float bhi(unsigned w) { return __uint_as_float(w & 0xffff0000u); }
template <int CTRL> __device__ __forceinline__ float ws_dpp_add(float v) { return v + __builtin_bit_cast(float, __builtin_amdgcn_update_dpp(0, __builtin_bit_cast(int, v), CTRL, 0xF, 0xF, true)); }
__device__ __forceinline__ float wave_sum(float v) {
    v = ws_dpp_add<0xB1>(v); v = ws_dpp_add<0x4E>(v); v = ws_dpp_add<0x141>(v); v = ws_dpp_add<0x140>(v);
    { const auto sw = __builtin_amdgcn_permlane16_swap(__float_as_uint(v), __float_as_uint(v), false, false); v = __uint_as_float(sw[0]) + __uint_as_float(sw[1]); }
    { const auto sw = __builtin_amdgcn_permlane32_swap(__float_as_uint(v), __float_as_uint(v), false, false); v = __uint_as_float(sw[0]) + __uint_as_float(sw[1]); }
    return v;
}
__device__ const unsigned char BUCKET[3][129] = {
{0,1,2,3,4,5,6,7,8,9,10,11,12,13,14,15,16,16,16,16,16,16,17,17,17,17,17,17,17,17,18,18,18,18,18,18,18,18,18,18,19,19,19,19,19,19,19,19,19,19,19,19,19,19,20,20,20,20,20,20,20,20,20,20,20,20,20,20,20,20,20,20,20,21,21,21,21,21,21,21,21,21,21,21,21,21,21,21,21,21,21,21,21,21,21,21,21,21,21,22,22,22,22,22,22,22,22,22,22,22,22,22,22,22,22,22,22,22,22,22,22,22,22,22,22,22,22,22,22},
{0,4,8,12,16,16,17,17,18,18,19,19,19,19,20,20,20,20,20,21,21,21,21,21,21,22,22,22,22,22,22,22,22,22,23,23,23,23,23,23,23,23,23,23,23,23,24,24,24,24,24,24,24,24,24,24,24,24,24,24,24,24,25,25,25,25,25,25,25,25,25,25,25,25,25,25,25,25,25,25,25,25,25,26,26,26,26,26,26,26,26,26,26,26,26,26,26,26,26,26,26,26,26,26,26,26,26,26,26,26,26,26,26,27,27,27,27,27,27,27,27,27,27,27,27,27,27,27,27},
{0,16,18,19,20,21,21,22,22,23,23,23,24,24,24,24,25,25,25,25,25,26,26,26,26,26,26,26,26,27,27,27,27,27,27,27,27,27,27,28,28,28,28,28,28,28,28,28,28,28,28,28,29,29,29,29,29,29,29,29,29,29,29,29,29,29,29,29,29,29,30,30,30,30,30,30,30,30,30,30,30,30,30,30,30,30,30,30,30,30,30,30,30,30,30,31,31,31,31,31,31,31,31,31,31,31,31,31,31,31,31,31,31,31,31,31,31,31,31,31,31,31,31,31,31,31,31,31,31}};

__device__ __forceinline__ void p0_transpose_item(const GAS float* W, int K, int N, GAS bf16* WT, LAS unsigned char* scr, int item, int lane, bool hperm = false) {
    const int nblk = N / 64, kb = item / nblk, nb = item % nblk, k0 = 64 * kb, n0 = 64 * nb;
    const GAS float* src = W + (size_t)(k0 + (lane >> 4)) * N + n0 + 4 * (lane & 15);
    f32x4 v[16];
#pragma unroll
    for (int i = 0; i < 16; ++i) v[i] = __builtin_nontemporal_load((const GAS f32x4*)(src + (size_t)(4 * i) * N));
#pragma unroll
    for (int i = 0; i < 16; ++i) *(LAS unsigned long long*)(scr + (4 * i + (lane >> 4)) * 160 + (lane & 15) * 8) = (unsigned long long)pk2(v[i].x, v[i].y) | ((unsigned long long)pk2(v[i].z, v[i].w) << 32);
    LDS_WAIT(); asm volatile("" ::: "memory");
    const LAS unsigned char* tb = scr + ((lane & 15) >> 2) * 160 + (16 * (lane >> 4) + 4 * (lane & 3)) * 2;
    v4u o[8];
#pragma unroll
    for (int j = 0; j < 8; ++j) { const s16x4t a = __builtin_bit_cast(s16x4t, __builtin_amdgcn_ds_read_tr16_b64_v4i16((LAS v4i16t*)(tb + (8 * j) * 160)));
        const s16x4t b = __builtin_bit_cast(s16x4t, __builtin_amdgcn_ds_read_tr16_b64_v4i16((LAS v4i16t*)(tb + (8 * j + 4) * 160)));
        o[j].x = (unsigned)(unsigned short)a[0] | ((unsigned)(unsigned short)a[1] << 16); o[j].y = (unsigned)(unsigned short)a[2] | ((unsigned)(unsigned short)a[3] << 16);
        o[j].z = (unsigned)(unsigned short)b[0] | ((unsigned)(unsigned short)b[1] << 16); o[j].w = (unsigned)(unsigned short)b[2] | ((unsigned)(unsigned short)b[3] << 16); }
    int nr = n0 + lane; if (hperm) nr = ((nr >> 7) & 15) * 512 + (nr >> 11) * 128 + (nr & 127);
    GAS v4u* dst = (GAS v4u*)(WT + (size_t)nr * K + k0);
#pragma unroll
    for (int j = 0; j < 8; ++j) dst[j] = o[j];
    LDS_WAIT(); asm volatile("" ::: "memory");
}
constexpr int NR = 4;
__device__ __forceinline__ void rms_rows_to_bf16(const GAS float* x, int m, int step, int mend, const f32x4 (&gv)[4], GAS bf16* o, GAS float* rsout, int lane) {
    f32x4 v[NR][4]; int mr[NR];
#pragma unroll
    for (int r = 0; r < NR; ++r) { mr[r] = (m + r * step < mend) ? m + r * step : m; const GAS f32x4* xr = (const GAS f32x4*)(x + (size_t)mr[r] * DM) + lane;
#pragma unroll
        for (int j = 0; j < 4; ++j) v[r][j] = __builtin_nontemporal_load(xr + 64 * j); }
#pragma unroll
    for (int r = 0; r < NR; ++r) { float s = 0.f;
#pragma unroll
        for (int j = 0; j < 4; ++j) s += (v[r][j].x * v[r][j].x + v[r][j].y * v[r][j].y) + (v[r][j].z * v[r][j].z + v[r][j].w * v[r][j].w);
        const float rs = 1.0f / sqrtf(wave_sum(s) * (1.0f / DM) + EPS);
        if (lane == 0) rsout[mr[r]] = rs;
        GAS unsigned long long* o8 = (GAS unsigned long long*)(o + (size_t)mr[r] * DM) + lane;
#pragma unroll
        for (int j = 0; j < 4; ++j) { const f32x4 ov = v[r][j] * rs * gv[j]; o8[64 * j] = (unsigned long long)pk2(ov.x, ov.y) | ((unsigned long long)pk2(ov.z, ov.w) << 32); } }
}
__device__ __forceinline__ void rms_rows_uy_to_bf16(const GAS bf16* u0, const GAS float* rs0, const f32x4 (&ig0)[4], const GAS bf16* y, int m, int step, int mend, const f32x4 (&gv)[4], GAS bf16* o, GAS float* rsout, int lane) {
    unsigned long long uu[NR][4], yy[NR][4]; int mr[NR]; float ir[NR];
#pragma unroll
    for (int r = 0; r < NR; ++r) { mr[r] = (m + r * step < mend) ? m + r * step : m; const GAS unsigned long long* ur = (const GAS unsigned long long*)(u0 + (size_t)mr[r] * DM) + lane; const GAS unsigned long long* yr = (const GAS unsigned long long*)(y + (size_t)mr[r] * DM) + lane;
        ir[r] = rs0[mr[r]];
#pragma unroll
        for (int j = 0; j < 4; ++j) { uu[r][j] = __builtin_nontemporal_load(ur + 64 * j); yy[r][j] = __builtin_nontemporal_load(yr + 64 * j); } }
#pragma unroll
    for (int r = 0; r < NR; ++r) { float s = 0.f; f32x4 v[4]; const float ix = 1.0f / ir[r];
#pragma unroll
        for (int j = 0; j < 4; ++j) { const unsigned al = (unsigned)uu[r][j], ah = (unsigned)(uu[r][j] >> 32), lo = (unsigned)yy[r][j], hi = (unsigned)(yy[r][j] >> 32);
            v[j] = (f32x4){blo(al), bhi(al), blo(ah), bhi(ah)} * ig0[j] * ix + (f32x4){blo(lo), bhi(lo), blo(hi), bhi(hi)}; s += (v[j].x * v[j].x + v[j].y * v[j].y) + (v[j].z * v[j].z + v[j].w * v[j].w); }
        const float rs = 1.0f / sqrtf(wave_sum(s) * (1.0f / DM) + EPS);
        if (lane == 0) rsout[mr[r]] = rs;
        GAS unsigned long long* o8 = (GAS unsigned long long*)(o + (size_t)mr[r] * DM) + lane;
#pragma unroll
        for (int j = 0; j < 4; ++j) { const f32x4 ov = v[j] * rs * gv[j]; o8[64 * j] = (unsigned long long)pk2(ov.x, ov.y) | ((unsigned long long)pk2(ov.z, ov.w) << 32); } }
}
__device__ __forceinline__ void rms_rows_xy_to_bf16(const GAS float* x, const GAS bf16* y, int m, int step, int mend, const f32x4 (&gv)[4], GAS bf16* o, GAS float* rsout, int lane) {
    f32x4 v[NR][4]; unsigned long long yy[NR][4]; int mr[NR];
#pragma unroll
    for (int r = 0; r < NR; ++r) { mr[r] = (m + r * step < mend) ? m + r * step : m; const GAS f32x4* xr = (const GAS f32x4*)(x + (size_t)mr[r] * DM) + lane; const GAS unsigned long long* yr = (const GAS unsigned long long*)(y + (size_t)mr[r] * DM) + lane;
#pragma unroll
        for (int j = 0; j < 4; ++j) { v[r][j] = xr[64 * j]; yy[r][j] = yr[64 * j]; } }
#pragma unroll
    for (int r = 0; r < NR; ++r) { float s = 0.f;
#pragma unroll
        for (int j = 0; j < 4; ++j) { const unsigned lo = (unsigned)yy[r][j], hi = (unsigned)(yy[r][j] >> 32);
            v[r][j] = v[r][j] + (f32x4){blo(lo), bhi(lo), blo(hi), bhi(hi)}; s += (v[r][j].x * v[r][j].x + v[r][j].y * v[r][j].y) + (v[r][j].z * v[r][j].z + v[r][j].w * v[r][j].w); }
        const float rs = 1.0f / sqrtf(wave_sum(s) * (1.0f / DM) + EPS);
        if (lane == 0) rsout[mr[r]] = rs;
        GAS unsigned long long* o8 = (GAS unsigned long long*)(o + (size_t)mr[r] * DM) + lane;
#pragma unroll
        for (int j = 0; j < 4; ++j) { const f32x4 ov = v[r][j] * rs * gv[j]; o8[64 * j] = (unsigned long long)pk2(ov.x, ov.y) | ((unsigned long long)pk2(ov.z, ov.w) << 32); } }
}
__device__ __forceinline__ void rms_rows_final(const GAS bf16* u1, const GAS float* rsin, const GAS bf16* y2, int m, int step, int mend, const f32x4 (&ig1)[4], const f32x4 (&gf)[4], GAS float* out, int lane) {
    unsigned long long uu[NR][4], yy[NR][4]; float rsv[NR]; int mr[NR];
#pragma unroll
    for (int r = 0; r < NR; ++r) { mr[r] = (m + r * step < mend) ? m + r * step : m; const GAS unsigned long long* ur = (const GAS unsigned long long*)(u1 + (size_t)mr[r] * DM) + lane; const GAS unsigned long long* yr = (const GAS unsigned long long*)(y2 + (size_t)mr[r] * DM) + lane;
        rsv[r] = rsin[mr[r]];
#pragma unroll
        for (int j = 0; j < 4; ++j) { uu[r][j] = __builtin_nontemporal_load(ur + 64 * j); yy[r][j] = __builtin_nontemporal_load(yr + 64 * j); } }
#pragma unroll
    for (int r = 0; r < NR; ++r) { const float ir = __builtin_amdgcn_rcpf(rsv[r]); f32x4 v[4]; float s = 0.f;
#pragma unroll
        for (int j = 0; j < 4; ++j) { const unsigned al = (unsigned)uu[r][j], ah = (unsigned)(uu[r][j] >> 32), bl = (unsigned)yy[r][j], bh = (unsigned)(yy[r][j] >> 32);
            v[j] = (f32x4){blo(al), bhi(al), blo(ah), bhi(ah)} * ig1[j] * ir + (f32x4){blo(bl), bhi(bl), blo(bh), bhi(bh)}; s += (v[j].x * v[j].x + v[j].y * v[j].y) + (v[j].z * v[j].z + v[j].w * v[j].w); }
        const float rs = 1.0f / sqrtf(wave_sum(s) * (1.0f / DM) + EPS);
        GAS f32x4* orw = (GAS f32x4*)(out + (size_t)mr[r] * DM) + lane;
#pragma unroll
        for (int j = 0; j < 4; ++j) __builtin_nontemporal_store(v[j] * rs * gf[j], orw + 64 * j); }
}
__device__ __forceinline__ void rms_row_inplace_f32(GAS float* xrow, const GAS float* g, int lane) {
    GAS f32x4* xr = (GAS f32x4*)xrow + lane; const GAS f32x4* gr = (const GAS f32x4*)g + lane;
    f32x4 v[4]; float s = 0.f;
#pragma unroll
    for (int j = 0; j < 4; ++j) { v[j] = xr[64 * j]; s += (v[j].x * v[j].x + v[j].y * v[j].y) + (v[j].z * v[j].z + v[j].w * v[j].w); }
    const float rs = 1.0f / sqrtf(wave_sum(s) * (1.0f / DM) + EPS);
#pragma unroll
    for (int j = 0; j < 4; ++j) { const f32x4 gv = gr[64 * j]; xr[64 * j] = v[j] * rs * gv; }
}

#define RLX_AGENT __ATOMIC_RELAXED, __HIP_MEMORY_SCOPE_AGENT
#define XB_TMO      128
#define XB_XCNT(j)  (256  + 64 * (j))
#define XB_XSUB(j)  (1280 + 64 * (j))
#define XB_XGEN(j)  (2304 + 64 * (j))
#define XB_TOP      3328
#define XB_TOPGEN   3392
#define XCD_BAR_WORDS 3456
#define XB_SPIN_CAP (1u << 18)

__device__ __forceinline__ unsigned xb_ld(unsigned* p)              { return __hip_atomic_load(p, __ATOMIC_RELAXED, __HIP_MEMORY_SCOPE_AGENT); }
__device__ __forceinline__ unsigned xb_add(unsigned* p, unsigned v) { return __hip_atomic_fetch_add(p, v, __ATOMIC_RELAXED, __HIP_MEMORY_SCOPE_AGENT); }
__device__ __forceinline__ unsigned xb_xcc_id() { return (unsigned)__builtin_amdgcn_s_getreg((3 << 11) | 20) & 0xFu; }
#define XB_SPIN(cond, bar) do { unsigned _sp = 0; while (cond) { __builtin_amdgcn_s_sleep(1); \
    if ((++_sp & 255u) == 0u) { if (xb_ld(&(bar)[XB_TMO])) break; if (_sp > XB_SPIN_CAP) { atomicAdd(&(bar)[XB_TMO], 1u); break; } } } } while (0)

struct XcdBarrier {
    unsigned* bar; unsigned x;
    volatile LAS unsigned* st;
};

__device__ __forceinline__ XcdBarrier xcd_barrier_post(unsigned* bar, volatile LAS unsigned* st) {
    XcdBarrier b; b.bar = bar; b.x = xb_xcc_id(); b.st = st;
    if (threadIdx.x == 0) (void)xb_add(&bar[XB_XCNT(b.x)], 1u);
    return b;
}
__device__ __forceinline__ void xcd_barrier_complete(unsigned* bar, unsigned x, unsigned& nloc, unsigned& nx) {
    const unsigned G = gridDim.x * gridDim.y * gridDim.z;
    unsigned sum, cnt, mine, sp = 0u;
    for (;;) {
        sum = 0u; cnt = 0u; mine = 0u;
#pragma unroll
        for (unsigned j = 0; j < 16; ++j) { const unsigned c = xb_ld(&bar[XB_XCNT(j)]); sum += c; cnt += (c > 0u) ? 1u : 0u; mine = (j == x) ? c : mine; }
        if (sum == G) break;
        __builtin_amdgcn_s_sleep(1);
        if ((++sp & 255u) == 0u) { if (xb_ld(&bar[XB_TMO])) break; if (sp > XB_SPIN_CAP) { atomicAdd(&bar[XB_TMO], 1u); break; } }
    }
    nloc = mine > 0u ? mine : 1u; nx = cnt > 0u ? cnt : 1u;
}

__device__ __forceinline__ void xcd_barrier(const XcdBarrier& b) {
    asm volatile("s_waitcnt vmcnt(0)" ::: "memory");
    __syncthreads();
    if (threadIdx.x == 0) {
        unsigned* bar = b.bar;
        __builtin_amdgcn_s_waitcnt(0);
        unsigned nloc = b.st[0], nx = b.st[1];
        if (nloc == 0u) { xcd_barrier_complete(bar, b.x, nloc, nx); b.st[0] = nloc; b.st[1] = nx; }
        const unsigned old = xb_add(&bar[XB_XSUB(b.x)], 1u);
        const unsigned gen = old / nloc;
        if (old + 1u == (gen + 1u) * nloc) {
            __builtin_amdgcn_fence(__ATOMIC_RELEASE, "agent");
            asm volatile("s_waitcnt vmcnt(0)" ::: "memory");
            const unsigned og = xb_add(&bar[XB_TOP], 1u);
            const unsigned tg = og / nx;
            if (og + 1u == (tg + 1u) * nx) xb_add(&bar[XB_TOPGEN], 1u);
            else XB_SPIN(xb_ld(&bar[XB_TOPGEN]) == tg, bar);
            __builtin_amdgcn_fence(__ATOMIC_ACQUIRE, "agent");
            xb_add(&bar[XB_XGEN(b.x)], 1u);
            asm volatile("s_waitcnt vmcnt(0)" ::: "memory");
        } else {
            XB_SPIN(xb_ld(&bar[XB_XGEN(b.x)]) == gen, bar);
            __builtin_amdgcn_fence(__ATOMIC_ACQUIRE, "agent");
            asm volatile("s_waitcnt vmcnt(0)" ::: "memory");
        }
    }
    __syncthreads();
}

constexpr int CW_BAR = 1024;
constexpr size_t CTL_ZERO_BYTES = 32768;
#ifndef HGABL
#define HGABL 0
#endif
#ifndef PHPROF_MASK
#define PHPROF_MASK 0u
#endif
#ifndef AABL
#define AABL 0
#endif
#ifndef REPEAT_MASK
#define REPEAT_MASK 0u
#endif
constexpr float LOG2E = 1.4426950408889634f, LN2 = 0.6931471805599453f;
typedef short bf16x8 __attribute__((ext_vector_type(8)));
typedef short s16x4 __attribute__((ext_vector_type(4)));
typedef float f32x16 __attribute__((ext_vector_type(16)));
typedef unsigned u32x2v __attribute__((ext_vector_type(2)));
typedef short v4i16_t __attribute__((ext_vector_type(4)));
__device__ __forceinline__ unsigned cvtpk(float lo, float hi) { unsigned r; asm volatile("v_cvt_pk_bf16_f32 %0, %1, %2" : "=v"(r) : "v"(lo), "v"(hi)); return r; }
typedef float f32x2_t __attribute__((ext_vector_type(2))); typedef __bf16 bf16x2_t __attribute__((ext_vector_type(2)));
__device__ __forceinline__ unsigned cvtpk_c(float lo, float hi) { const f32x2_t v = {lo, hi}; const bf16x2_t b = __builtin_convertvector(v, bf16x2_t); return __builtin_bit_cast(unsigned, b); }
__device__ __forceinline__ bf16x8 pack8(float a0, float a1, float a2, float a3, float a4, float a5, float a6, float a7) {
    v4u w; w.x = cvtpk(a0, a1); w.y = cvtpk(a2, a3); w.z = cvtpk(a4, a5); w.w = cvtpk(a6, a7); return __builtin_bit_cast(bf16x8, w);
}
__device__ __forceinline__ int crow(int r) { return (r & 3) + 8 * (r >> 2); }
__device__ __forceinline__ s16x4 vtr(const LAS unsigned char* p) { return __builtin_bit_cast(s16x4, __builtin_amdgcn_ds_read_tr16_b64_v4i16((LAS v4i16_t*)p)); }
__device__ __forceinline__ void glds16(const GAS void* gsrc, unsigned lds_dst) { unsigned keep;
    asm volatile("s_mov_b32 %0, m0\n\ts_mov_b32 m0, %2\n\ts_nop 0\n\tglobal_load_lds_dwordx4 %1, off\n\ts_mov_b32 m0, %0" : "=&s"(keep) : "v"(gsrc), "s"(lds_dst) : "memory"); }
#define LDS_BAR() do { asm volatile("s_waitcnt lgkmcnt(0)" ::: "memory"); __builtin_amdgcn_s_barrier(); asm volatile("" ::: "memory"); } while (0)
#define VM_WAIT_N(n) asm volatile("s_waitcnt vmcnt(" #n ")" ::: "memory")

constexpr int H3_SLOT = 32768;
constexpr int H3_QF = 98304, H3_KIF = 106496, H3_KDF = 114688, H3_OB = 122880, H3_OBLD = 272  , H3_OBB = 32 * H3_OBLD  , H3_TT = H3_OB + 2 * H3_OBB, H3_AD = H3_TT + 2048, H3_FL = H3_AD + 512, H3_END = H3_FL + 16;
static_assert(H3_END <= TAB_OFF, "HGRN LDS map");
constexpr size_t WS_HGU = 67 * MiB, WS_HGA = 83 * MiB;
#ifndef PROF_SEL
#define PROF_SEL 0
#endif
#define PROF_T0(k) unsigned long long t0_##k = 0; if (PROF_SEL == k && OUT) { asm volatile("s_memrealtime %0\n\ts_waitcnt lgkmcnt(0)" : "=s"(t0_##k) :: "memory"); }
#define PROF_T1(k) if (PROF_SEL == k && OUT) { unsigned long long t1_; asm volatile("s_memrealtime %0\n\ts_waitcnt lgkmcnt(0)" : "=s"(t1_) :: "memory"); prof_acc += (unsigned)(t1_ - t0_##k); }
template <int CTRL> __device__ __forceinline__ float dpp_add(float v) { return v + __builtin_bit_cast(float, __builtin_amdgcn_update_dpp(0, __builtin_bit_cast(int, v), CTRL, 0xF, 0xF, true)); }
__device__ __forceinline__ float lane_xor16(float v, int lane) { const auto sw = __builtin_amdgcn_permlane16_swap(__float_as_uint(v), __float_as_uint(v), false, false); return __uint_as_float(((lane >> 4) & 1) ? sw[0] : sw[1]); }
__device__ __forceinline__ float lane_xor32(float v, int lane) { const auto sw = __builtin_amdgcn_permlane32_swap(__float_as_uint(v), __float_as_uint(v), false, false); return __uint_as_float((lane >> 5) ? sw[0] : sw[1]); }
template <bool OUT, int ABL = 0>
__device__ __forceinline__ unsigned hgrn_pass(LAS unsigned char* lds, int item, int tid, const GAS bf16* __restrict__ qfig, const GAS float* __restrict__ lb_logits, const GAS float* __restrict__ norm_g, GAS float* __restrict__ Ust, GAS float* __restrict__ Ast, GAS bf16* __restrict__ y) {
    unsigned prof_acc = 0;
    const int h = item >> 4, J = item & 15;
    const int lane = tid & 63, w = __builtin_amdgcn_readfirstlane(tid >> 6), l15 = lane & 15, q4 = lane >> 4;
    const int col = 16 * w + l15, cq = q4;
    const int eg = 16 * w + l15;
    const unsigned lds0 = (unsigned)(size_t)lds;
    constexpr int ROWB = OUT ? 1024 : 512, H3_TQ = 0, H3_TF = OUT ? 256 : 0, H3_TV = OUT ? 512 : 256, H3_TG = 768;
    const GAS char* base = (const GAS char*)(qfig + ((size_t)h * SEQ + (size_t)(J * 1024)) * 512);
    const GAS char* dsrc = OUT ? base + (size_t)(4 * w) * 1024 + lane * 16 : base + (size_t)(4 * w + (lane >> 5)) * 1024 + 256 + (lane & 31) * 16;
#define HG_DMA(chunk_, slot_) do { const GAS char* s_ = dsrc + (size_t)(chunk_) * 32768; const unsigned d_ = lds0 + (unsigned)(slot_) * H3_SLOT + (unsigned)w * (4u * ROWB); \
        if (OUT) { glds16(s_, d_); glds16(s_ + 1024, d_ + 1024); glds16(s_ + 2048, d_ + 2048); glds16(s_ + 3072, d_ + 3072); } else { glds16(s_, d_); glds16(s_ + 2048, d_ + 1024); } } while (0)
    HG_DMA(OUT ? 0 : 31, 0); HG_DMA(OUT ? 1 : 30, 1);
    float lb;
    { const int gc = h * 128 + col; const float l0 = lb_logits[gc], l1 = lb_logits[DI + gc], l2 = lb_logits[2 * DI + gc];
      const float mx = fmaxf(l0, fmaxf(l1, l2)); const float e0 = __expf(l0 - mx), e1 = __expf(l1 - mx), e2 = __expf(l2 - mx); lb = e0 * __builtin_amdgcn_rcpf(e0 + e1 + e2); }
    const float omlb = 1.0f - lb;
    int off8[8];
    { const int ks = col >> 5, tq = (col >> 2) & 3, jjd = 4 * ((col >> 4) & 1) + (col & 3);
#pragma unroll
      for (int cc = 0; cc < 8; ++cc) { const int c = 8 * cq + cc; off8[cc] = c * 256 + (((ks * 4 + tq) ^ (c & 15)) * 16) + jjd * 2; } }
    f32x4 S[8];
#pragma unroll
    for (int dt = 0; dt < 8; ++dt) S[dt] = (f32x4){0.f, 0.f, 0.f, 0.f};
    if (OUT) {
        f32x4 P[8];
#pragma unroll
        for (int dt = 0; dt < 8; ++dt) P[dt] = (f32x4){1.f, 1.f, 1.f, 1.f};
        for (int Jp = J - 1; Jp >= 0; --Jp) { const GAS f32x4* Uf = (const GAS f32x4*)(Ust + (size_t)(h * 16 + Jp) * 16384) + (w * 8) * 64 + lane; const GAS float* Ab = Ast + (h * 16 + Jp) * 128;
            bool nz = false;
            f32x4 uu[8], aa[8];
#pragma unroll
            for (int dt = 0; dt < 8; ++dt) { uu[dt] = Uf[dt * 64]; aa[dt] = *(const GAS f32x4*)(Ab + 16 * dt + 4 * q4); }
            asm volatile("" : "+v"(uu[0]), "+v"(uu[1]), "+v"(uu[2]), "+v"(uu[3]), "+v"(uu[4]), "+v"(uu[5]), "+v"(uu[6]), "+v"(uu[7]));
            asm volatile("" : "+v"(aa[0]), "+v"(aa[1]), "+v"(aa[2]), "+v"(aa[3]), "+v"(aa[4]), "+v"(aa[5]), "+v"(aa[6]), "+v"(aa[7]));
#pragma unroll
            for (int dt = 0; dt < 8; ++dt) { const f32x4 u = uu[dt]; const f32x4 a = aa[dt]; S[dt] += P[dt] * u; P[dt] *= a;
                nz = nz || (P[dt][0] != 0.f) || (P[dt][1] != 0.f) || (P[dt][2] != 0.f) || (P[dt][3] != 0.f); }
            if (!__any(nz)) break; }
    }
    const int pc = tid >> 4, pe = tid & 15;
    f32x4 ng0 = (f32x4){0.f, 0.f, 0.f, 0.f}, ng1 = ng0;
    if (OUT) { ng0 = *(const GAS f32x4*)(norm_g + h * 128 + 8 * pe); ng1 = *(const GAS f32x4*)(norm_g + h * 128 + 8 * pe + 4); }
    const int p1off = (8 * cq + (l15 >> 2)) * ROWB + (16 * w + 4 * (l15 & 3)) * 2;
    const int vfoff = (4 * q4 + (l15 >> 2)) * ROWB + (16 * w + 4 * (l15 & 3)) * 2;
    asm volatile("s_waitcnt vmcnt(0)" ::: "memory");
    float sufP = 1.f;
    if (!OUT) { unsigned z; asm volatile("v_mov_b32 %0, 0" : "=v"(z));
        if (tid == 0) { ((LAS unsigned*)(lds + H3_FL))[0] = z; ((LAS unsigned*)(lds + H3_FL))[1] = z; } }
    if (OUT) VM_WAIT_N(4); else VM_WAIT_N(2);
    LDS_BAR();
#define HG_Y(ov, gn, g) ((ov) * rs * (gn) * (g) * __builtin_amdgcn_rcpf(1.0f + __builtin_amdgcn_exp2f((g) * -LOG2E)))
#define HG_FINISH(OBT_, G4_, NC_) do { const v4u ow_ = *(const LAS v4u*)((OBT_) + pc * H3_OBLD + pe * 16); \
        const float a0 = blo(ow_.x), a1 = bhi(ow_.x), a2 = blo(ow_.y), a3 = bhi(ow_.y), a4 = blo(ow_.z), a5 = bhi(ow_.z), a6 = blo(ow_.w), a7 = bhi(ow_.w); \
        float ss = (a0 * a0 + a1 * a1) + (a2 * a2 + a3 * a3) + (a4 * a4 + a5 * a5) + (a6 * a6 + a7 * a7); \
        ss = dpp_add<0xB1>(ss); ss = dpp_add<0x4E>(ss); ss = dpp_add<0x141>(ss); ss = dpp_add<0x140>(ss); \
        const float rs = __builtin_amdgcn_rsqf(ss * (1.0f / 128.0f) + EPS); \
        const float g0 = blo((G4_).x), g1 = bhi((G4_).x), g2 = blo((G4_).y), g3 = bhi((G4_).y), g4 = blo((G4_).z), g5 = bhi((G4_).z), g6 = blo((G4_).w), g7 = bhi((G4_).w); \
        v4u yo; yo.x = cvtpk(HG_Y(a0, ng0.x, g0), HG_Y(a1, ng0.y, g1)); yo.y = cvtpk(HG_Y(a2, ng0.z, g2), HG_Y(a3, ng0.w, g3)); \
        yo.z = cvtpk(HG_Y(a4, ng1.x, g4), HG_Y(a5, ng1.y, g5)); yo.w = cvtpk(HG_Y(a6, ng1.z, g6), HG_Y(a7, ng1.w, g7)); \
        *(GAS v4u*)(y + (size_t)(J * 1024 + (NC_) * 32 + pc) * DI + h * 128 + 8 * pe) = yo; } while (0)
    for (int it = 0; it < 32; ++it) {
        const int n = OUT ? it : 31 - it;
        const LAS unsigned char* slot = lds + (it % 3) * H3_SLOT;
        PROF_T0(1)
        v4u gw4 = (v4u){0u, 0u, 0u, 0u};
        if (OUT && it > 0) gw4 = *(const LAS v4u*)(lds + ((it - 1) % 3) * H3_SLOT + H3_TG + pc * ROWB + pe * 16);
        PROF_T1(1)
        PROF_T0(2)
        { float qv[8], kv[8], cs[8];
          const s16x4 f0 = vtr(slot + H3_TF + p1off), f1 = vtr(slot + H3_TF + p1off + 4 * ROWB);
          s16x4 q0 = (s16x4){0, 0, 0, 0}, q1 = q0; if (OUT) { q0 = vtr(slot + H3_TQ + p1off); q1 = vtr(slot + H3_TQ + p1off + 4 * ROWB); }
#pragma unroll
          for (int cc = 0; cc < 8; ++cc) {
              const float fp = bf2f((unsigned short)(cc < 4 ? f0[cc] : f1[cc - 4])); qv[cc] = OUT ? bf2f((unsigned short)(cc < 4 ? q0[cc] : q1[cc - 4])) : 0.f;
              const float f = __builtin_fmaf(omlb, __builtin_amdgcn_rcpf(1.0f + __builtin_amdgcn_exp2f(fp * -LOG2E)), lb);
              kv[cc] = 1.0f - f; cs[cc] = cc ? cs[cc - 1] * f : f; }
          const float T = cs[7];
          const float Ta = lane_xor16(T, lane), P = T * Ta, Pq = lane_xor32(P, lane);
          const float off = cq == 0 ? 1.f : cq == 1 ? Ta : cq == 2 ? Pq : Pq * Ta;
          const float total = P * Pq;
          if (OUT) { if (cq == 0) ((LAS float*)(lds + H3_AD))[col] = total; }
          float kd[8];
          const float kbase = OUT ? total : sufP * total;
#pragma unroll
          for (int cc = 0; cc < 8; ++cc) { const float eb = off * cs[cc], enb = __builtin_amdgcn_rcpf(eb);
              kd[cc] = kv[cc] * (kbase * enb);
              if (OUT) { const float qd = qv[cc] * eb, ki = kv[cc] * enb;
                  *(LAS unsigned short*)(lds + H3_QF + off8[cc]) = (unsigned short)cvtpk(qd, qd);
                  *(LAS unsigned short*)(lds + H3_KIF + off8[cc]) = (unsigned short)cvtpk(ki, ki); } }
          if (!OUT) { sufP *= total;
              if (tid == 0) ((LAS unsigned*)(lds + H3_FL))[(it + 1) & 1] = 0u;
              if (sufP != 0.0f) ((LAS unsigned*)(lds + H3_FL))[it & 1] = 1u; }
          const int i4 = 4 * (cq >> 1), qa = 2 * (cq & 1), sw = (col >> 2) & 3;
          u32x2v w0, w1;
          w0.x = cvtpk(kd[0], kd[1]); w0.y = cvtpk(kd[2], kd[3]); w1.x = cvtpk(kd[4], kd[5]); w1.y = cvtpk(kd[6], kd[7]);
          *(LAS u32x2v*)(lds + H3_KDF + col * 64 + ((qa ^ sw) * 16) + i4 * 2) = w0;
          *(LAS u32x2v*)(lds + H3_KDF + col * 64 + (((qa + 1) ^ sw) * 16) + i4 * 2) = w1; }
        PROF_T1(2)
        PROF_T0(3)
        LDS_BAR();
        PROF_T1(3)
        PROF_T0(4)
        { const int nx = it + 2 < 32 ? it + 2 : 31; HG_DMA(OUT ? nx : 31 - nx, (it + 2) % 3); }
        PROF_T1(4)
        PROF_T0(5)
        if (PROF_SEL == 7 && OUT) { __builtin_amdgcn_sched_barrier(0); }
        if (PROF_SEL == 8 && OUT) { asm volatile("s_waitcnt lgkmcnt(0)" ::: "memory"); }
        if (PROF_SEL == 9 && OUT) { prof_acc += (unsigned)__builtin_amdgcn_s_memrealtime() & 1u; }
        bf16x8 vfrag;
        { const s16x4 v0 = vtr(slot + H3_TV + vfoff), v1 = vtr(slot + H3_TV + vfoff + 16 * ROWB); vfrag = (bf16x8){v0[0], v0[1], v0[2], v0[3], v1[0], v1[1], v1[2], v1[3]}; }
        if (OUT) {
            if (it > 0) HG_FINISH(lds + H3_OB + ((it - 1) & 1) * H3_OBB, gw4, n - 1);
            bf16x8 qf[2][4], kif[2][4];
#pragma unroll
            for (int jt = 0; jt < 2; ++jt)
#pragma unroll
                for (int ks = 0; ks < 4; ++ks) { const int c = 16 * jt + l15; const int byte = c * 256 + (((ks * 4 + q4) ^ (c & 15)) * 16);
                    qf[jt][ks] = *(const LAS bf16x8*)(lds + H3_QF + byte); kif[jt][ks] = *(const LAS bf16x8*)(lds + H3_KIF + byte); }
            f32x4 sc[2][2];
#pragma unroll
            for (int i = 0; i < 2; ++i)
#pragma unroll
                for (int jt = 0; jt < 2; ++jt) sc[i][jt] = (f32x4){0.f, 0.f, 0.f, 0.f};
#pragma unroll
            for (int ks = 0; ks < 4; ++ks)
#pragma unroll
                for (int i = 0; i < 2; ++i)
#pragma unroll
                    for (int jt = 0; jt < 2; ++jt) sc[i][jt] = __builtin_amdgcn_mfma_f32_16x16x32_bf16(kif[i][ks], qf[jt][ks], sc[i][jt], 0, 0, 0);
            f32x4 o[2];
#pragma unroll
            for (int jt = 0; jt < 2; ++jt) { const int c = 16 * jt + l15; float pm[8];
#pragma unroll
                for (int r = 0; r < 4; ++r) { pm[r] = (4 * q4 + r <= c) ? sc[0][jt][r] : 0.f; pm[4 + r] = (16 + 4 * q4 + r <= c) ? sc[1][jt][r] : 0.f; }
                const bf16x8 pf = pack8(pm[0], pm[1], pm[2], pm[3], pm[4], pm[5], pm[6], pm[7]);
                o[jt] = __builtin_amdgcn_mfma_f32_16x16x32_bf16(pf, vfrag, (f32x4){0.f, 0.f, 0.f, 0.f}, 0, 0, 0); }
#pragma unroll
            for (int ks = 0; ks < 4; ++ks) { const bf16x8 sb = pack8(S[2 * ks][0], S[2 * ks][1], S[2 * ks][2], S[2 * ks][3], S[2 * ks + 1][0], S[2 * ks + 1][1], S[2 * ks + 1][2], S[2 * ks + 1][3]);
#pragma unroll
                for (int jt = 0; jt < 2; ++jt) o[jt] = __builtin_amdgcn_mfma_f32_16x16x32_bf16(qf[jt][ks], sb, o[jt], 0, 0, 0); }
#pragma unroll
            for (int jt = 0; jt < 2; ++jt)
#pragma unroll
                for (int r = 0; r < 4; ++r) *(LAS unsigned short*)(lds + H3_OB + (it & 1) * H3_OBB + (16 * jt + 4 * q4 + r) * H3_OBLD + eg * 2) = (unsigned short)cvtpk_c(o[jt][r], o[jt][r]);
        }
        { bf16x8 kdfv[8]; f32x4 avv[8];
#pragma unroll
          for (int dt = 0; dt < 8; ++dt) { const int d = 16 * dt + l15;
              kdfv[dt] = *(const LAS bf16x8*)(lds + H3_KDF + d * 64 + ((q4 ^ ((d >> 2) & 3)) * 16));
              if (OUT) avv[dt] = *(const LAS f32x4*)(lds + H3_AD + (16 * dt + 4 * q4) * 4); }
          asm volatile("" : "+v"(kdfv[0]), "+v"(kdfv[1]), "+v"(kdfv[2]), "+v"(kdfv[3]), "+v"(kdfv[4]), "+v"(kdfv[5]), "+v"(kdfv[6]), "+v"(kdfv[7]));
          if (OUT) {
#pragma unroll
              for (int dt = 0; dt < 8; ++dt) S[dt] *= avv[dt]; }
#pragma unroll
          for (int dt = 0; dt < 8; ++dt) {
              if (dt < 7) asm volatile("v_mfma_f32_16x16x32_bf16 %0, %1, %2, %0" : "+v"(S[dt]) : "v"(kdfv[dt]), "v"(vfrag));
              else asm volatile("v_mfma_f32_16x16x32_bf16 %0, %1, %2, %0\n\ts_nop 11" : "+v"(S[dt]) : "v"(kdfv[dt]), "v"(vfrag)); } }
        if (!OUT) { if (((volatile LAS unsigned*)(lds + H3_FL))[it & 1] == 0u) break; }
        PROF_T1(5)
        PROF_T0(6)
        if (OUT) VM_WAIT_N(4); else VM_WAIT_N(2);
        LDS_BAR();
        PROF_T1(6)
    }
    if (OUT) {
        const v4u gl = *(const LAS v4u*)(lds + (31 % 3) * H3_SLOT + H3_TG + pc * ROWB + pe * 16);
        HG_FINISH(lds + H3_OB + (31 & 1) * H3_OBB, gl, 31);
    }
#undef HG_FINISH
#undef HG_Y
#undef HG_DMA
    asm volatile("s_waitcnt vmcnt(0)" ::: "memory");
    LDS_BAR();
    if (!OUT) {
        GAS f32x4* Uf = (GAS f32x4*)(Ust + (size_t)(h * 16 + J) * 16384) + (w * 8) * 64 + lane;
#pragma unroll
        for (int dt = 0; dt < 8; ++dt) Uf[dt * 64] = S[dt];
        if (cq == 0) Ast[(h * 16 + J) * 128 + col] = sufP;
    }
    return prof_acc;
}
constexpr int A3_RT = 0, A3_RING = 1024, A3_NR = 5, A3_PD = 4, A3_SLOT = 16384, A3_STG = A3_RING + A3_NR * A3_SLOT, A3_STGB = 8192 + 256, A3_END = A3_STG + 8 * A3_STGB;
static_assert(A3_END <= TAB_OFF, "attention LDS map");
constexpr float QSCALE = 0.08838834764831845f * LOG2E;
__device__ __forceinline__ void glds4(const GAS void* gsrc, unsigned lds_dst) { unsigned keep;
    asm volatile("s_mov_b32 %0, m0\n\ts_mov_b32 m0, %2\n\ts_nop 0\n\tglobal_load_lds_dword %1, off\n\ts_mov_b32 m0, %0" : "=&s"(keep) : "v"(gsrc), "s"(lds_dst) : "memory"); }
__device__ __forceinline__ float mul_s(float a, float b) { float r; asm("v_mul_f32_e32 %0, %1, %2" : "=v"(r) : "v"(a), "v"(b)); return r; }
__device__ __forceinline__ float fma_s(float a, float b, float c) { float r; asm("v_fma_f32 %0, %1, %2, %3" : "=v"(r) : "v"(a), "v"(b), "v"(c)); return r; }
__device__ __forceinline__ void glds16s(const GAS void* sbase, unsigned voff, unsigned lds_dst) { unsigned keep;
    asm volatile("s_mov_b32 %0, m0\n\ts_mov_b32 m0, %3\n\ts_nop 0\n\tglobal_load_lds_dwordx4 %1, %2 nt\n\ts_mov_b32 m0, %0" : "=&s"(keep) : "v"(voff), "s"(sbase), "s"(lds_dst) : "memory"); }
__device__ __forceinline__ void glds4s(const GAS void* sbase, unsigned voff, unsigned lds_dst) { unsigned keep;
    asm volatile("s_mov_b32 %0, m0\n\ts_mov_b32 m0, %3\n\ts_nop 0\n\tglobal_load_lds_dword %1, %2 nt\n\ts_mov_b32 m0, %0" : "=&s"(keep) : "v"(voff), "s"(sbase), "s"(lds_dst) : "memory"); }
#ifndef APROF_W
#define APROF_W 0
#endif
#ifndef APROF_SEL
#define APROF_SEL 0
#endif
#define APROF_T0(k) unsigned long long at0_##k = 0; if (APROF_SEL == k) { asm volatile("s_memrealtime %0\n\ts_waitcnt lgkmcnt(0)" : "=s"(at0_##k) :: "memory"); }
#define APROF_T1(k) if (APROF_SEL == k) { unsigned long long t1_; asm volatile("s_memrealtime %0\n\ts_waitcnt lgkmcnt(0)" : "=s"(t1_) :: "memory"); aprof += (unsigned)(t1_ - at0_##k); }
__device__ __forceinline__ unsigned attn_phase(LAS unsigned char* lds, int vb, int G, int tid, const GAS bf16* __restrict__ qkv, const GAS float* __restrict__ rel_bias, GAS bf16* __restrict__ oacc_all, GAS float* __restrict__ lse_all, int g, int merge) {
    unsigned aprof = 0;
    const int lane = tid & 63, w = __builtin_amdgcn_readfirstlane(tid >> 6);
    const int ldil = 2 * g, dil = 1 << ldil, nqb = 512 >> ldil, L = SEQ >> ldil;
    LAS float* RT = (LAS float*)(lds + A3_RT);
    const unsigned lds0 = (unsigned)(size_t)lds;
    LAS unsigned char* stg = lds + A3_STG + w * A3_STGB;
    const unsigned stg0 = lds0 + A3_STG + (unsigned)w * A3_STGB;
    const int lq = 6, QPI = 1 << lq, ipb = 8192 >> lq, JN = QPI >> 3;
    const int nqm = nqb - 1, lnq = 9 - ldil;
    for (int bi = vb; bi < 2 * ipb; bi += G) {
        APROF_T0(3)
        const int bat = bi >= ipb ? 1 : 0; GAS bf16* oacc = oacc_all + (size_t)bat * SEQ * DI; GAS float* lseacc = lse_all + (size_t)bat * SEQ * 16;
        const int it0 = (bi - bat * ipb) << lq; const int h = it0 >> 9; const int rres = (it0 & 511) >> (9 - ldil), mb0 = it0 & (nqb - 1);
        const int kt_lo = mb0 > 4 ? mb0 - 4 : 0, NS = mb0 + QPI - kt_lo;
        __syncthreads();
        const size_t rowbase = ((size_t)h * T + (size_t)bat * SEQ + (size_t)rres * L) * 256;
        const GAS char* qpl = (const GAS char*)qkv + rowbase;
        const GAS char* kpl = (const GAS char*)qkv + (size_t)16 * T * 256 + rowbase;
        const GAS char* vpl = (const GAS char*)qkv + (size_t)32 * T * 256 + rowbase;
#define A3_TILE(k_) do { int lt_ = lane; asm volatile("" : "+v"(lt_)); const int pr_ = lt_ >> 4, pp_ = lt_ & 15; \
            const int kro = (4 * w + pr_) * 256 + ((pp_ ^ ((4 * w + pr_) & 15)) * 16), vro = (4 * w + pr_) * 256 + ((pp_ ^ ((pr_ & 3) << 2)) * 16); \
            const int kk_ = (k_) < NS ? (k_) : NS - 1; const size_t to_ = (size_t)(kt_lo + kk_) * 8192; const unsigned sl_ = lds0 + A3_RING + (unsigned)((k_) % A3_NR) * A3_SLOT + (unsigned)w * 1024u; \
            glds16s(kpl + to_, (unsigned)kro, sl_); glds16s(vpl + to_, (unsigned)vro, sl_ + 8192u); } while (0)
#define A3_QDMA(mb_) do { int lt_ = lane; asm volatile("" : "+v"(lt_)); const int pr_ = lt_ >> 4, pp_ = lt_ & 15; _Pragma("unroll") for (int j_ = 0; j_ < 8; ++j_) glds16s(qpl + (size_t)(mb_) * 8192, (unsigned)((4 * j_ + pr_) * 256 + ((pp_ ^ ((4 * j_ + pr_) & 15)) * 16)), stg0 + j_ * 1024); } while (0)
#define A3_ODMA(mb_) do { int lt_ = lane; asm volatile("" : "+v"(lt_)); const int pr_ = lt_ >> 4, pp_ = lt_ & 15, ql_ = lt_ & 31; _Pragma("unroll") for (int j_ = 0; j_ < 8; ++j_) glds16s((const GAS char*)(oacc + ((size_t)h * SEQ + (size_t)(32 * ((mb_) & nqm) * dil + rres + ((mb_) >> lnq))) * 128), (unsigned)((4 * j_ + pr_) * dil * 256 + ((pp_ ^ ((4 * j_ + pr_) & 15)) * 16)), stg0 + j_ * 1024); \
            glds4s((const GAS char*)(lseacc + (size_t)h * SEQ + (size_t)(32 * ((mb_) & nqm) * dil + rres + ((mb_) >> lnq))), (unsigned)(ql_ * dil * 4), stg0 + 8192); } while (0)
        int mb = mb0 + ((w & 3) * 2 + (w >> 2)), sstart = -1;
        int e0 = 0, e1 = 0, e2 = 0, e3 = 0;
        A3_QDMA(mb);
#pragma unroll
        for (int k = 0; k < A3_PD; ++k) A3_TILE(k);
        { int t2 = tid; asm volatile("" : "+v"(t2));
          if (t2 < 191) { const int rel = 159 - t2; RT[t2] = (rel >= 0 && rel <= 128) ? rel_bias[(int)BUCKET[g][rel] * 48 + g * 16 + h] * LOG2E : -1e30f; } }
        asm volatile("s_waitcnt vmcnt(0)" ::: "memory");
        __syncthreads();
        bf16x8 qf[8]; f32x16 o[4]; float m = -1e30f, l = 0.f;
#pragma unroll
        for (int ks = 0; ks < 8; ++ks) qf[ks] = (bf16x8){0, 0, 0, 0, 0, 0, 0, 0};
#pragma unroll
        for (int db = 0; db < 4; ++db)
#pragma unroll
            for (int r = 0; r < 16; ++r) o[db][r] = 0.f;
#define A3_START(NW_, kk_) do { VM_WAIT_N(NW_); int lx_ = lane; asm volatile("" : "+v"(lx_) :: "memory"); const int qx_ = lx_ & 31, hx_ = lx_ >> 5; \
            _Pragma("unroll") for (int ks = 0; ks < 8; ++ks) qf[ks] = *(const LAS bf16x8*)(stg + qx_ * 256 + (((2 * ks + hx_) ^ (qx_ & 15)) * 16)); \
            _Pragma("unroll") for (int db = 0; db < 4; ++db) _Pragma("unroll") for (int r = 0; r < 16; ++r) o[db][r] = 0.f; \
            m = -1e30f; l = 0.f; sstart = (kk_); asm volatile("s_waitcnt lgkmcnt(0)" ::: "memory"); if (merge) A3_ODMA(mb); } while (0)
#define A3_STEP() do { APROF_T0(1) APROF_T0(6) { const int ex = e0 + e1 + e2 + e3; if (ex == 0) VM_WAIT_N(6); else if (ex == 8) VM_WAIT_N(14); else if (ex == 9) VM_WAIT_N(15); else VM_WAIT_N(23); } APROF_T1(6) \
            APROF_T0(7) e0 = e1; e1 = e2; e2 = e3; e3 = 0; LDS_BAR(); APROF_T1(7) APROF_T1(1) APROF_T0(5) A3_TILE(k + A3_PD); APROF_T1(5) } while (0)
        int k = 0;
        for (int jb = 0; jb < JN; ++jb) {
            const int first = (mb - 4) > (mb & ~nqm) ? mb - 4 : (mb & ~nqm);
            if (jb == 0 && first == kt_lo) { A3_START(8, -1); if (merge) e3 = 9; }
            else {
                while (kt_lo + k < first - 1) { A3_STEP(); ++k; }
                A3_STEP(); APROF_T0(8) A3_START(4, k); if (merge) e3 = 9; APROF_T1(8) ++k;
            }
            for (; kt_lo + k <= mb; ++k) {
                A3_STEP();
                const int kt = kt_lo + k;
                const LAS unsigned char* slot = lds + A3_RING + (k % A3_NR) * A3_SLOT;
                APROF_T0(10)
                const int delta = mb - kt;
                int lx = lane; asm volatile("" : "+v"(lx));
                const int qx = lx & 31, hx = lx >> 5;
                f32x16 s;
                { const LAS float* rt = RT + (159 - (32 * delta + qx - 4 * hx));
#pragma unroll
                  for (int r = 0; r < 16; ++r) s[r] = rt[crow(r)]; }
                bf16x8 kf[8];
#pragma unroll
                for (int ks = 0; ks < 8; ++ks) kf[ks] = *(const LAS bf16x8*)(slot + qx * 256 + (((2 * ks + hx) ^ (qx & 15)) * 16));
                asm volatile("" : "+v"(kf[0]), "+v"(kf[1]), "+v"(kf[2]), "+v"(kf[3]), "+v"(kf[4]), "+v"(kf[5]), "+v"(kf[6]), "+v"(kf[7]));
#pragma unroll
                for (int ks = 0; ks < 8; ++ks) s = __builtin_amdgcn_mfma_f32_32x32x16_bf16(kf[ks], qf[ks], s, 0, 0, 0);
                float mx = s[0];
#pragma unroll
                for (int r = 1; r < 16; ++r) mx = fmaxf(mx, s[r]);
                { const auto sw = __builtin_amdgcn_permlane32_swap(__float_as_uint(mx), __float_as_uint(mx), false, false); mx = fmaxf(__uint_as_float(sw[0]), __uint_as_float(sw[1])); }
                if (kt == first) m = mx;
                else if (__any(mx > m + 8.0f)) { const float mn = fmaxf(m, mx); const float alpha = __builtin_amdgcn_exp2f(m - mn); m = mn; l *= alpha;
#pragma unroll
                    for (int db = 0; db < 4; ++db)
#pragma unroll
                        for (int r = 0; r < 16; ++r) o[db][r] *= alpha; }
                float rs = 0.f;
#pragma unroll
                for (int r = 0; r < 16; ++r) { s[r] = __builtin_amdgcn_exp2f(s[r] - m); rs += s[r]; }
                l += rs;
                const bf16x8 pb0 = pack8(s[0], s[1], s[2], s[3], s[4], s[5], s[6], s[7]), pb1 = pack8(s[8], s[9], s[10], s[11], s[12], s[13], s[14], s[15]);
                const int ix = lx & 15, gx = (lx >> 4) & 1;
#pragma unroll
                for (int db = 0; db < 4; ++db) {
                    const LAS unsigned char* vp = slot + (8192 + (4 * hx + (ix >> 2)) * 256 + ((4 * (db ^ (ix >> 2)) + 2 * gx + ((ix & 3) >> 1)) * 16) + (ix & 1) * 8); asm volatile("" : "+v"(vp));
                    const s16x4 a0 = vtr(vp), a1 = vtr(vp + 8 * 256);
                    const s16x4 b0 = vtr(vp + 16 * 256), b1 = vtr(vp + 24 * 256);
                    const bf16x8 va0 = (bf16x8){a0[0], a0[1], a0[2], a0[3], a1[0], a1[1], a1[2], a1[3]}, va1 = (bf16x8){b0[0], b0[1], b0[2], b0[3], b1[0], b1[1], b1[2], b1[3]};
                    o[db] = __builtin_amdgcn_mfma_f32_32x32x16_bf16(va0, pb0, o[db], 0, 0, 0);
                    o[db] = __builtin_amdgcn_mfma_f32_32x32x16_bf16(va1, pb1, o[db], 0, 0, 0);
                }
                APROF_T1(10)
            }
            {
                A3_STEP();
                APROF_T0(9)
                __builtin_amdgcn_s_setprio(3);
                int lx = lane; asm volatile("" : "+v"(lx)); const int qx = lx & 31, hx = lx >> 5;
                { const auto sw = __builtin_amdgcn_permlane32_swap(__float_as_uint(l), __float_as_uint(l), false, false); l = __uint_as_float(sw[0]) + __uint_as_float(sw[1]); }
                const float lse = (m + __builtin_amdgcn_logf(l)) * LN2;
                float wa = 0.f, wg = __builtin_amdgcn_rcpf(l), ln = lse;
                if (merge) {
                    if (k - sstart == 6) VM_WAIT_N(12); else VM_WAIT_N(0);
                    asm volatile("" ::: "memory");
                    u32x2v av[16];
#pragma unroll
                    for (int c = 0; c < 16; ++c) av[c] = *(const LAS u32x2v*)(stg + qx * 256 + ((c ^ (qx & 15)) * 16) + hx * 8);
                    const float la = *(const LAS float*)(stg + 8192 + 4 * qx); const float mm = fmaxf(la, lse);
                    ln = mm + LN2 * __builtin_amdgcn_logf(__builtin_amdgcn_exp2f((la - mm) * LOG2E) + __builtin_amdgcn_exp2f((lse - mm) * LOG2E));
                    wa = __builtin_amdgcn_exp2f((la - ln) * LOG2E); wg = __builtin_amdgcn_exp2f((lse - ln) * LOG2E) * wg;
#pragma unroll
                    for (int db = 0; db < 4; ++db)
#pragma unroll
                        for (int rq = 0; rq < 4; ++rq) { LAS u32x2v* p = (LAS u32x2v*)(stg + qx * 256 + (((4 * db + rq) ^ (qx & 15)) * 16) + hx * 8); const u32x2v a = av[4 * db + rq];
                            u32x2v rr; rr.x = cvtpk(fma_s(wa, blo(a.x), mul_s(wg, o[db][4 * rq + 0])), fma_s(wa, bhi(a.x), mul_s(wg, o[db][4 * rq + 1])));
                            rr.y = cvtpk(fma_s(wa, blo(a.y), mul_s(wg, o[db][4 * rq + 2])), fma_s(wa, bhi(a.y), mul_s(wg, o[db][4 * rq + 3])));
                            *p = rr; }
                } else {
#pragma unroll
                    for (int db = 0; db < 4; ++db)
#pragma unroll
                        for (int rq = 0; rq < 4; ++rq) { LAS u32x2v* p = (LAS u32x2v*)(stg + qx * 256 + (((4 * db + rq) ^ (qx & 15)) * 16) + hx * 8);
                            u32x2v rr; rr.x = cvtpk(mul_s(wg, o[db][4 * rq + 0]), mul_s(wg, o[db][4 * rq + 1])); rr.y = cvtpk(mul_s(wg, o[db][4 * rq + 2]), mul_s(wg, o[db][4 * rq + 3]));
                            *p = rr; }
                }
                if (hx == 0) lseacc[(size_t)h * SEQ + (size_t)((32 * (mb & nqm) + qx) * dil + rres + (mb >> lnq))] = ln;
                asm volatile("s_waitcnt lgkmcnt(0)" ::: "memory");
                { const int pr_ = lx >> 4, pp_ = lx & 15; GAS char* ob = (GAS char*)(oacc + ((size_t)h * SEQ + (size_t)(32 * (mb & nqm) * dil + rres + (mb >> lnq))) * 128);
                  v4u wv[8];
#pragma unroll
                  for (int j = 0; j < 8; ++j) wv[j] = *(const LAS v4u*)(stg + (4 * j + pr_) * 256 + pp_ * 16);
#pragma unroll
                  for (int j = 0; j < 8; ++j) { const int rr = 4 * j + pr_; *(GAS v4u*)(ob + (unsigned)(rr * dil * 256 + ((pp_ ^ (rr & 15)) * 16))) = wv[j]; } }
                asm volatile("s_waitcnt lgkmcnt(0)" ::: "memory");
                mb += 8;
                if (jb + 1 < JN) { A3_QDMA(mb); e3 = 8; }
                __builtin_amdgcn_s_setprio(0);
                APROF_T1(9)
                ++k;
            }
        }
        while (k <= NS) { A3_STEP(); ++k; }
#undef A3_STEP
#undef A3_START
#undef A3_TILE
#undef A3_QDMA
#undef A3_ODMA
        asm volatile("s_waitcnt vmcnt(0)" ::: "memory");
        __syncthreads();
        APROF_T1(3)
#if APROF_SEL
        if (lane == 0) ((LAS unsigned*)(lds + 800))[w] = aprof;
#endif
    }
#if APROF_SEL
    __syncthreads(); aprof = ((LAS unsigned*)(lds + 800))[APROF_W]; __syncthreads();
#endif
    return aprof;
}
#ifndef FAST_HG
#define FAST_HG 1
#endif
#ifndef FAST_ATT
#define FAST_ATT 1
#endif
__device__ __forceinline__ GAS void* ldp(LAS unsigned char* lds, int i) {
    const unsigned long long v = ((LAS unsigned long long*)(lds + TAB_OFF))[i];
    const unsigned lo = __builtin_amdgcn_readfirstlane((unsigned)v), hi = __builtin_amdgcn_readfirstlane((unsigned)(v >> 32));
    return (GAS void*)(((unsigned long long)hi << 32) | lo);
}
struct Args { const float* in[10]; float* out; unsigned char* ws; int lo, hi; };
__global__ void __launch_bounds__(NWAVES * 64, 2) fwd(Args args) {
    extern __shared__ __attribute__((aligned(16))) unsigned char lds_raw[];
    LAS unsigned char* lds = (LAS unsigned char*)lds_raw;
    cg::grid_group grid = cg::this_grid();
    const int tid0 = threadIdx.x;
    const int G = gridDim.x; const int bx = blockIdx.x;
    const int vcu = (G % 8 == 0) ? (bx % 8) * (G / 8) + bx / 8 : bx;
    const int NGW = G * NWAVES;
    { LAS unsigned long long* P = (LAS unsigned long long*)(lds + TAB_OFF);
      if (tid0 < 10) P[tid0] = (unsigned long long)args.in[tid0];
      if (tid0 == 10) P[10] = (unsigned long long)args.out;
      if (tid0 == 11) P[11] = (unsigned long long)args.ws;
      if (tid0 == 12) { ((LAS unsigned*)(lds + TAB_OFF + 256))[0] = 0u; ((LAS unsigned*)(lds + TAB_OFF + 256))[1] = 0u; }
      __syncthreads(); }
    (void)xcd_barrier_post((unsigned*)(args.ws + WS_CTL) + CW_BAR, (volatile LAS unsigned*)(lds + TAB_OFF + 256));
    const int ph_hi = args.hi;
    unsigned prof_total = 0;
    int ph = args.lo, rep = 0;
    while (ph < ph_hi) {
        unsigned long long pht0 = 0; const int ph_cur = ph;
        if (PHPROF_MASK) { asm volatile("s_memrealtime %0\n\ts_waitcnt lgkmcnt(0)" : "=s"(pht0) :: "memory"); }
        int tid = threadIdx.x; asm volatile("" : "+v"(tid) :: "memory");
        const int lane = tid & 63, wave = __builtin_amdgcn_readfirstlane(tid >> 6), gw = vcu * NWAVES + wave;
        const GAS float* x = (const GAS float*)ldp(lds, 0); const GAS float* ln_g = (const GAS float*)ldp(lds, 1);
        GAS unsigned char* ws = (GAS unsigned char*)ldp(lds, 11); GAS float* Hres = (GAS float*)ldp(lds, 10); GAS bf16* U0 = (GAS bf16*)Hres;
        GAS bf16* Whgin = (GAS bf16*)(ws + WS_WHGIN); GAS bf16* Whgout = (GAS bf16*)(ws + WS_WHGOUT); GAS bf16* Wattin = (GAS bf16*)(ws + WS_WATTIN); GAS bf16* Wattout = (GAS bf16*)(ws + WS_WATTOUT);
        GAS bf16* QFIG = (GAS bf16*)(ws + WS_BIG0); GAS bf16* U1 = (GAS bf16*)(ws + WS_U1); GAS bf16* QKV = (GAS bf16*)(ws + WS_QKV); GAS bf16* YB = (GAS bf16*)(ws + WS_BIG1);
        if (ph == PH_PRO) {
            LAS unsigned char* scr = lds + wave * 16384;
            const GAS float* hg_w_in = (const GAS float*)ldp(lds, 2);
            constexpr int I_A = (DM / 64) * (HG_COLS / 64);
            for (int it = gw; it < I_A; it += NGW) p0_transpose_item(hg_w_in, DM, HG_COLS, Whgin, scr, it, lane, true);
            { f32x4 gv[4]; const GAS f32x4* gr = (const GAS f32x4*)ln_g + lane;
#pragma unroll
              for (int j = 0; j < 4; ++j) gv[j] = gr[64 * j];
              for (int m = gw; m < SEQ; m += NR * NGW) rms_rows_to_bf16(x, m, NGW, SEQ, gv, U0, (GAS float*)(ws + WS_RS0), lane); }
        } else if (ph == PH_G1_0 || ph == PH_G1_1) {
            const int b = (ph == PH_G1_1);
            const pg8::Gemm g{U0 + (size_t)b * SEQ * DM, Whgin, SEQ, HG_COLS, DM}; const pg8::EpiBf16 E{QFIG, 512, 0, 1.0f, SEQ, 0, SEQ};
            pg8::StaticOrder S; S.init(SEQ, HG_COLS, G, bx);
            pg8::gemm_phase<pg8::EpiBf16, pg8::StaticOrder, PG8_ALIGN, PG8_SP2>(lds, g, S, E);
        } else if (ph >= PH_G3_0 && ph < PH_GATE && ((ph - PH_G3_0) & 1) == 0) {
            const int gi = 2 - ((ph - PH_G3_0) >> 1);
            const pg8::Gemm g{U1, Wattin + (size_t)gi * QKV_COLS * DM, T, QKV_COLS, DM}; const pg8::EpiBf16 E{QKV, QKV_COLS, DI, QSCALE, -T, 2 * gi, SEQ};
            pg8::StaticOrder S; S.init(T, QKV_COLS, G, bx);
            pg8::gemm_phase<pg8::EpiBf16, pg8::StaticOrder, PG8_ALIGN, PG8_SP2>(lds, g, S, E);
        } else if (ph == PH_G2 || ph == PH_G5) {
            pg8::Gemm g{ph == PH_G2 ? YB : (GAS bf16*)(ws + WS_Y2), ph == PH_G2 ? Whgout : Wattout, T, DM, DI};
            GAS bf16* yo = ph == PH_G2 ? (GAS bf16*)(ws + WS_Y1) : (GAS bf16*)(ws + WS_Y2P);
            const pg8::EpiBf16Split E{yo, yo + (size_t)SEQ * DM, DM, SEQ};
            pg8::StaticOrder S; S.init(T, DM, G, bx);
            pg8::gemm_phase<pg8::EpiBf16Split, pg8::StaticOrder, PG8_ALIGN, PG8_SP2>(lds, g, S, E);
        } else if (ph == PH_GATE) {
            pg8::Gemm g{U1, Wattin + (size_t)3 * QKV_COLS * DM, T, DI, DM};
            pg8::EpiGateMul E{(const GAS bf16*)Hres, (GAS bf16*)(ws + WS_Y2), DI, SEQ};
            pg8::StaticOrder S; S.init(T, DI, G, bx);
            pg8::gemm_phase<pg8::EpiGateMul, pg8::StaticOrder, PG8_ALIGN, PG8_SP2>(lds, g, S, E);
        } else if (ph == PH_HGA_0 || ph == PH_HGA_1 || ph == PH_HGB_0 || ph == PH_HGB_1) {
            const int b = (ph >= PH_G1_1); const bool outp = (ph == PH_HGB_0 || ph == PH_HGB_1);
            const GAS float* lbl = (const GAS float*)ldp(lds, 3); const GAS float* ngp = (const GAS float*)ldp(lds, 4);
#if FAST_HG
            GAS float* Ust = (GAS float*)(ws + WS_HGU); GAS float* Ast = (GAS float*)(ws + WS_HGA);
            for (int item = vcu; item < 256; item += G) {
                if (outp) prof_total += hgrn_pass<true>(lds, item, tid, QFIG, lbl, ngp, Ust, Ast, YB + (size_t)b * SEQ * DI);
                else hgrn_pass<false>(lds, item, tid, QFIG, lbl, ngp, Ust, Ast, YB + (size_t)b * SEQ * DI);
            }
            if (ph == PH_HGA_0) {
                LAS unsigned char* scr = lds + wave * 16384;
                const GAS float* hg_w_out = (const GAS float*)ldp(lds, 5); const GAS float* att_w_in = (const GAS float*)ldp(lds, 6); const GAS float* att_w_out = (const GAS float*)ldp(lds, 7);
                constexpr int I_B = (DI / 64) * (DM / 64), I_C = (DM / 64) * (ATT_COLS / 64), I_D = I_B;
                for (int it = gw; it < I_B + I_C + I_D; it += NGW) {
                    int r = it;
                    if (r < I_B) { p0_transpose_item(hg_w_out, DI, DM, Whgout, scr, r, lane); continue; } r -= I_B;
                    if (r < I_C) { p0_transpose_item(att_w_in, DM, ATT_COLS, Wattin, scr, r, lane); continue; } r -= I_C;
                    p0_transpose_item(att_w_out, DI, DM, Wattout, scr, r, lane);
                }
                { f32x4 gv[4]; const GAS f32x4* gr = (const GAS f32x4*)ln_g + lane;
#pragma unroll
                  for (int j = 0; j < 4; ++j) gv[j] = gr[64 * j];
                  for (int m = SEQ + gw; m < T; m += NR * NGW) rms_rows_to_bf16(x, m, NGW, T, gv, U0, (GAS float*)(ws + WS_RS0), lane); }
            }
#endif
        } else if (ph >= PH_G3_0 && ph < PH_GATE && ((ph - PH_G3_0) & 1) == 1) {
            const int gi = 2 - ((ph - PH_G3_0) >> 1);
            prof_total += attn_phase(lds, vcu, G, tid, QKV, (const GAS float*)ldp(lds, 8), (GAS bf16*)Hres, (GAS float*)(ws + WS_LSE), gi, ph > PH_G3_0 + 1);
        } else if (ph == PH_NORM1) {
            { f32x4 gv[4]; const GAS f32x4* gr = (const GAS f32x4*)(ln_g + DM) + lane;
#pragma unroll
              for (int j = 0; j < 4; ++j) gv[j] = gr[64 * j];
              const GAS bf16* Y1 = (const GAS bf16*)(ws + WS_Y1); GAS float* RS = (GAS float*)(ws + WS_RS);
              f32x4 ig0[4]; { const GAS f32x4* g0r = (const GAS f32x4*)ln_g + lane;
#pragma unroll
                for (int j = 0; j < 4; ++j) { const f32x4 gg = g0r[64 * j]; ig0[j] = (f32x4){1.0f / gg.x, 1.0f / gg.y, 1.0f / gg.z, 1.0f / gg.w}; } }
              for (int m = gw; m < T; m += NR * NGW) rms_rows_uy_to_bf16(U0, (const GAS float*)(ws + WS_RS0), ig0, Y1, m, NGW, T, gv, U1, RS, lane); }
        } else if (ph == PH_FINAL) {
            f32x4 ig1[4], gf[4];
            { const GAS f32x4* g1r = (const GAS f32x4*)(ln_g + DM) + lane; const GAS f32x4* gfr = (const GAS f32x4*)ldp(lds, 9) + lane;
#pragma unroll
              for (int j = 0; j < 4; ++j) { const f32x4 gg = g1r[64 * j]; ig1[j] = (f32x4){1.0f / gg.x, 1.0f / gg.y, 1.0f / gg.z, 1.0f / gg.w}; gf[j] = gfr[64 * j]; } }
            { const GAS float* RS = (const GAS float*)(ws + WS_RS); const GAS bf16* Y2P = (const GAS bf16*)(ws + WS_Y2P);
              for (int m = gw; m < T; m += NR * NGW) rms_rows_final(U1, RS, Y2P, m, NGW, T, ig1, gf, Hres, lane); }
        }
        if (((REPEAT_MASK >> ph) & 1u) && rep == 0) rep = 1; else { rep = 0; ++ph; }
        if (ph < ph_hi) {
            if (ph_hi < 0) grid.sync();
            else { XcdBarrier xb; xb.bar = (unsigned*)((GAS unsigned char*)ldp(lds, 11) + WS_CTL) + CW_BAR; xb.x = xb_xcc_id(); xb.st = (volatile LAS unsigned*)(lds + TAB_OFF + 256); xcd_barrier(xb); }
        }
        if (PHPROF_MASK && ((PHPROF_MASK >> ph_cur) & 1u)) { unsigned long long t1_; asm volatile("s_memrealtime %0\n\ts_waitcnt lgkmcnt(0)" : "=s"(t1_) :: "memory"); prof_total += (unsigned)(t1_ - pht0); }
    }
#if PROF_SEL || APROF_SEL || PHPROF_MASK
    if (bx == 0 && threadIdx.x == 0) { const unsigned long long t0 = __builtin_amdgcn_s_memrealtime(); const unsigned long long want = 4ull * prof_total; while (__builtin_amdgcn_s_memrealtime() - t0 < want) __builtin_amdgcn_s_sleep(8); }
#endif
}

extern "C" void kernel_launch(void* const* d_in, const int* in_sizes, int n_in, void* d_out, int out_size, void* d_ws, size_t ws_size, hipStream_t stream) {
    static int grid = 0;
    if (grid == 0) {
        if (n_in != 10 || out_size != T * DM || ws_size < WS_END) { fprintf(stderr, "kernel_launch: unexpected shapes (n_in %d out %d ws %zu)\n", n_in, out_size, ws_size); grid = -1; return; }
        int dev = 0, cus = 0, per_cu = 0;
        hipGetDevice(&dev); hipDeviceGetAttribute(&cus, hipDeviceAttributeMultiprocessorCount, dev);
        if (hipFuncSetAttribute((const void*)fwd, hipFuncAttributeMaxDynamicSharedMemorySize, LDS_BYTES) != hipSuccess) { fprintf(stderr, "kernel_launch: hipFuncSetAttribute failed\n"); grid = -1; return; }
        hipOccupancyMaxActiveBlocksPerMultiprocessor(&per_cu, (const void*)fwd, NWAVES * 64, LDS_BYTES);
        if (per_cu < 1) { fprintf(stderr, "kernel_launch: occupancy query reports %d blocks per CU\n", per_cu); per_cu = 1; }
        (void)hipGetLastError();
        grid = cus * per_cu;
    }
    if (grid < 0) return;
    Args a{};
    for (int i = 0; i < 10; ++i) a.in[i] = (const float*)d_in[i];
    a.out = (float*)d_out; a.ws = (unsigned char*)d_ws;
    a.lo = PH_PRO; a.hi = PH_END;
    if (hipMemsetAsync((char*)d_ws + WS_CTL, 0, CTL_ZERO_BYTES, stream) != hipSuccess) { fprintf(stderr, "kernel_launch: hipMemsetAsync failed\n"); return; }
    void* kargs[] = {&a};
    const hipError_t le = hipLaunchCooperativeKernel((const void*)fwd, dim3(grid), dim3(NWAVES * 64), kargs, LDS_BYTES, stream);
    if (le != hipSuccess) fprintf(stderr, "kernel_launch: cooperative launch failed: %s (grid %d)\n", hipGetErrorString(le), grid);
}
```
